# Optimizing an MI355X kernel written in HIP

```python
import math
import jax, jax.numpy as jnp
from jax import lax
import numpy as np

D_MODEL = 2048
BATCH = 2
SEQ = 8192
DEPTH = 2

PLE_DIM = 256
D_FF = 4 * D_MODEL
D_MIX = D_MODEL
GROUP_WIDTH = D_MIX // 4
NORM_EPS = 1e-6

A_HEADS = 4
A_DV = GROUP_WIDTH // A_HEADS
A_DH = A_DV // 2
A_QK = A_HEADS * 2 * A_DH
A_IN = 2 * A_QK + A_HEADS * A_DV
Q_BLOCK = 128
NUM_BUCKETS = 32
MAX_DISTANCE = 128

H_HEADS = 4
H_DK = GROUP_WIDTH // H_HEADS
H_DV = H_DK
H_CHUNK = 64
H_IN = 5 * GROUP_WIDTH

POOL_WINDOWS = (2, 4, 8, 16)
C_GROUP = GROUP_WIDTH // len(POOL_WINDOWS)
C_IN = GROUP_WIDTH

R_HEADS = 8
R_DH = GROUP_WIDTH // R_HEADS
R_DECAY_LORA = 64
R_ICLR_LORA = 64
R_GATE_LORA = 128
R_SPLITS = (GROUP_WIDTH, GROUP_WIDTH, GROUP_WIDTH, R_DECAY_LORA, R_DECAY_LORA, R_ICLR_LORA, R_ICLR_LORA, R_GATE_LORA)
R_IN = sum(R_SPLITS)
R_DECAY_SCALE = math.exp(-0.5)
R_GN_EPS = 64e-5

GROUP_SPLITS = (A_IN, H_IN, C_IN, R_IN)
N_IN = sum(GROUP_SPLITS)

kernel_name = 'hybrid_parallel_heads_bidir_encoder'


def split_last(t, sizes):
    return jnp.split(t, [int(o) for o in np.cumsum(sizes)[:-1]], axis=-1)


def rmsnorm(x, g, eps=NORM_EPS):
    xf = x.astype(jnp.float32)
    y = xf * lax.rsqrt(jnp.mean(xf * xf, axis=-1, keepdims=True) + eps)
    return (y * g.astype(jnp.float32)).astype(x.dtype)


def t5_bucket(rel):
    half = NUM_BUCKETS // 2
    max_exact = half // 2
    n = jnp.abs(rel)
    nf = jnp.maximum(n, 1).astype(jnp.float32)
    large = max_exact + (jnp.log(nf / max_exact) / math.log(MAX_DISTANCE / max_exact) * (half - max_exact)).astype(jnp.int32)
    large = jnp.minimum(large, half - 1)
    return jnp.where(rel > 0, half, 0) + jnp.where(n < max_exact, n, large)


def diff_attention(za, rel_bias, q_gain, k_gain, lam_p, subln_g, layer_idx):
    b_, s_, _ = za.shape
    nb = s_ // Q_BLOCK
    q, k, v = split_last(za, (A_QK, A_QK, A_HEADS * A_DV))
    q = rmsnorm(q.reshape(b_, s_, A_HEADS, 2, A_DH), q_gain)
    k = rmsnorm(k.reshape(b_, s_, A_HEADS, 2, A_DH), k_gain)
    v_t = v.reshape(b_, s_, A_HEADS, A_DV).transpose(0, 2, 1, 3)
    k_t = k.transpose(0, 2, 3, 1, 4)
    q_blocks = q.reshape(b_, nb, Q_BLOCK, A_HEADS, 2, A_DH).transpose(1, 0, 3, 4, 2, 5)
    lam_init = 0.8 - 0.6 * math.exp(-0.3 * layer_idx)
    lp = lam_p.astype(jnp.float32)
    lam = jnp.exp(jnp.sum(lp[0] * lp[1])) - jnp.exp(jnp.sum(lp[2] * lp[3])) + lam_init
    scale = A_DH ** -0.5
    k_pos = jnp.arange(s_, dtype=jnp.int32)
    table = rel_bias.astype(jnp.float32)

    def block(args):
        q_blk, bi = args
        q_pos = bi * Q_BLOCK + jnp.arange(Q_BLOCK, dtype=jnp.int32)
        bias = jnp.moveaxis(table[t5_bucket(k_pos[None, :] - q_pos[:, None])], -1, 0)
        logits = jnp.einsum('bhmqd,bhmkd->bhmqk', q_blk, k_t).astype(jnp.float32) * scale + bias[None, :, None]
        probs = jax.nn.softmax(logits, axis=-1).astype(v_t.dtype)
        o = jnp.einsum('bhmqk,bhkv->bhmqv', probs, v_t)
        return o[:, :, 0] - lam.astype(o.dtype) * o[:, :, 1]

    o = lax.map(block, (q_blocks, jnp.arange(nb, dtype=jnp.int32)))
    o = o.transpose(1, 0, 3, 2, 4).reshape(b_, s_, A_HEADS, A_DV)
    o = rmsnorm(o, subln_g) * (1.0 - lam_init)
    return o.reshape(b_, s_, A_HEADS * A_DV)


def hgrn2(zh, lb, o_gain):
    b_, s_, _ = zh.shape
    nc = s_ // H_CHUNK
    hq, hf_fwd, hf_bwd, hi, hg = split_last(zh, (GROUP_WIDTH,) * 5)
    lb = lb.astype(jnp.float32)
    log_lb = jnp.log(lb)
    log_ub = jnp.log1p(-lb)

    def gates(zf):
        zf = zf.astype(jnp.float32)
        log_f = jnp.logaddexp(log_lb, log_ub + jax.nn.log_sigmoid(zf))
        k_in = (1.0 - lb) * jax.nn.sigmoid(-zf)
        return log_f, k_in

    lf_f, k_f = gates(hf_fwd)
    lf_b, k_b = gates(hf_bwd)
    q = jax.nn.silu(hq.astype(jnp.float32))
    v = hi.astype(jnp.float32)

    def to_chunks(t_fwd, t_bwd, d):
        t = jnp.stack([t_fwd, jnp.flip(t_bwd, axis=1)])
        return t.reshape(2, b_, nc, H_CHUNK, H_HEADS, d).transpose(2, 0, 1, 4, 3, 5)

    xs = (to_chunks(q, q, H_DK), to_chunks(k_f, k_b, H_DK), to_chunks(v, v, H_DV), to_chunks(lf_f, lf_b, H_DK))
    causal = jnp.tril(jnp.ones((H_CHUNK, H_CHUNK), dtype=bool))

    def step(state, inp):
        qc, kc, vc, lfc = inp
        bcum = jnp.cumsum(lfc, axis=-2)
        o_inter = jnp.einsum('zbhtd,zbhdv->zbhtv', qc * jnp.exp(bcum), state)
        diff = bcum[..., :, None, :] - bcum[..., None, :, :]
        decay = jnp.exp(jnp.where(causal[:, :, None], diff, -jnp.inf))
        att = jnp.einsum('zbhtd,zbhsd,zbhtsd->zbhts', qc, kc, decay)
        o = o_inter + jnp.einsum('zbhts,zbhsv->zbhtv', att, vc)
        b_last = bcum[..., -1:, :]
        state = state * jnp.exp(b_last[..., 0, :])[..., None] + jnp.einsum('zbhsd,zbhsv->zbhdv', kc * jnp.exp(b_last - bcum), vc)
        return state, o

    s0 = jnp.zeros((2, b_, H_HEADS, H_DK, H_DV), jnp.float32)
    _, outs = lax.scan(step, s0, xs)
    outs = outs.transpose(1, 2, 0, 4, 3, 5).reshape(2, b_, s_, H_HEADS, H_DV)
    o = outs[0] + jnp.flip(outs[1], axis=1)
    o = rmsnorm(o, o_gain) * jax.nn.silu(hg.astype(jnp.float32)).reshape(b_, s_, H_HEADS, H_DV)
    return o.reshape(b_, s_, GROUP_WIDTH).astype(zh.dtype)


def pool_mixer(zc, w_grp, b_grp, ls):
    b_, s_, _ = zc.shape
    zf = zc.astype(jnp.float32)
    csum = jnp.concatenate([jnp.zeros((b_, 1, C_IN), jnp.float32), jnp.cumsum(zf, axis=1)], axis=1)
    t = jnp.arange(s_)
    outs = []
    for gi, w in enumerate(POOL_WINDOWS):
        sl = slice(gi * C_GROUP, (gi + 1) * C_GROUP)
        lo = jnp.clip(t - w // 2, 0, s_ - 1)
        hi = jnp.clip(t + (w - w // 2 - 1), 0, s_ - 1)
        cg = csum[..., sl]
        mean = (jnp.take(cg, hi + 1, axis=1) - jnp.take(cg, lo, axis=1)) / (hi - lo + 1).astype(jnp.float32)[None, :, None]
        outs.append(jnp.einsum('bsc,cd->bsd', mean - zf[..., sl], w_grp[gi].astype(jnp.float32)))
    out = (jnp.concatenate(outs, axis=-1) + b_grp.astype(jnp.float32)) * ls.astype(jnp.float32)
    return out.astype(zc.dtype)


def rwkv7(zr, mu, w0, w2, a0, a2, g2, k_k, k_a, r_k, gn_g, gn_b):
    b_, s_, _ = zr.shape
    f32 = jnp.float32
    zf = zr.astype(f32)
    mu = mu.astype(f32)
    z_prev = jnp.pad(zf[:, :-1], ((0, 0), (1, 0), (0, 0)))
    z_next = jnp.pad(zf[:, 1:], ((0, 0), (0, 1), (0, 0)))
    z = zf + mu[0] * (z_prev - zf) + mu[1] * (z_next - zf)
    r, k, v, wl_f, wl_b, al_f, al_b, gl = split_last(z, R_SPLITS)
    w0, w2, a0, a2 = w0.astype(f32), w2.astype(f32), a0.astype(f32), a2.astype(f32)

    def decay(wl, d):
        return jnp.exp(-R_DECAY_SCALE * jax.nn.sigmoid(w0[d] + jnp.tanh(wl) @ w2[d]))

    def iclr(al, d):
        return jax.nn.sigmoid(a0[d] + al @ a2[d])

    def heads(t):
        return t.reshape(b_, s_, R_HEADS, R_DH)

    w_f, w_b = decay(wl_f, 0), decay(wl_b, 1)
    a_f, a_b = iclr(al_f, 0), iclr(al_b, 1)
    g = jax.nn.sigmoid(gl) @ g2.astype(f32)
    k_k, k_a, r_k = k_k.astype(f32), k_a.astype(f32), r_k.astype(f32)
    kk = heads(k * k_k)
    kk = kk * lax.rsqrt(jnp.sum(kk * kk, axis=-1, keepdims=True) + 1e-12)
    ke_f = k * (1.0 + (a_f - 1.0) * k_a)
    ke_b = k * (1.0 + (a_b - 1.0) * k_a)

    def to_time(t_fwd, t_bwd):
        t = jnp.stack([t_fwd, jnp.flip(t_bwd, axis=1)])
        return t.transpose(2, 0, 1, 3, 4)

    rh, vh = heads(r), heads(v)
    xs = (to_time(rh, rh), to_time(heads(w_f), heads(w_b)), to_time(kk, kk),
          to_time(kk * heads(a_f), kk * heads(a_b)), to_time(vh, vh), to_time(heads(ke_f), heads(ke_b)))

    def step(state, inp):
        r_t, w_t, kk_t, b_t, v_t, k_t = inp
        sa = jnp.einsum('zbhvk,zbhk->zbhv', state, kk_t)
        state = state * w_t[..., None, :] - sa[..., None] * b_t[..., None, :] + v_t[..., None] * k_t[..., None, :]
        y = jnp.einsum('zbhvk,zbhk->zbhv', state, r_t)
        return state, y

    s0 = jnp.zeros((2, b_, R_HEADS, R_DH, R_DH), f32)
    _, ys = lax.scan(step, s0, xs)
    y = (ys[:, 0] + jnp.flip(ys[:, 1], axis=0)).transpose(1, 0, 2, 3)
    mean = jnp.mean(y, axis=-1, keepdims=True)
    var = jnp.mean(jnp.square(y - mean), axis=-1, keepdims=True)
    y = ((y - mean) * lax.rsqrt(var + R_GN_EPS)).reshape(b_, s_, GROUP_WIDTH) * gn_g.astype(f32) + gn_b.astype(f32)
    bonus = jnp.sum(heads(r * (0.5 * (ke_f + ke_b)) * r_k), axis=-1, keepdims=True) * vh
    out = (y + bonus.reshape(b_, s_, GROUP_WIDTH)) * g
    return out.astype(zr.dtype)


def setup_inputs(seed: int = 0) -> dict:
    key = jax.random.key(seed)
    ks = list(jax.random.split(key, 40))

    def nrm(idx, shape, scale):
        return jax.random.normal(ks[idx], shape, jnp.float32) * scale

    def gain(idx, shape):
        return 1.0 + 0.1 * jax.random.normal(ks[idx], shape, jnp.float32)

    return {
        'x': nrm(0, (BATCH, SEQ, D_MODEL), 1.0),
        'p': nrm(1, (DEPTH, BATCH, SEQ, PLE_DIM), 1.0),
        'mix_norm_g': gain(2, (DEPTH, D_MODEL)),
        'w_in': nrm(3, (DEPTH, D_MODEL, N_IN), D_MODEL ** -0.5),
        'w_out': nrm(4, (DEPTH, D_MIX, D_MODEL), D_MIX ** -0.5),
        'rel_bias': nrm(5, (NUM_BUCKETS, A_HEADS), 0.5),
        'a_qnorm': gain(6, (DEPTH, A_DH)),
        'a_knorm': gain(7, (DEPTH, A_DH)),
        'a_lambda': nrm(8, (DEPTH, 4, A_DH), 0.1),
        'a_subln': gain(9, (DEPTH, A_DV)),
        'h_lb_logits': nrm(10, (DEPTH, GROUP_WIDTH), 0.5),
        'h_onorm': gain(11, (DEPTH, H_DV)),
        'c_w': nrm(12, (DEPTH, len(POOL_WINDOWS), C_GROUP, C_GROUP), C_GROUP ** -0.5),
        'c_b': nrm(13, (DEPTH, C_IN), 0.02),
        'c_scale': gain(14, (DEPTH, C_IN)),
        'r_mu': jax.random.uniform(ks[15], (DEPTH, 2, R_IN), jnp.float32, 0.0, 0.5),
        'r_w0': nrm(16, (DEPTH, 2, GROUP_WIDTH), 0.5),
        'r_w2': nrm(17, (DEPTH, 2, R_DECAY_LORA, GROUP_WIDTH), 0.1),
        'r_a0': nrm(18, (DEPTH, 2, GROUP_WIDTH), 0.5),
        'r_a2': nrm(19, (DEPTH, 2, R_ICLR_LORA, GROUP_WIDTH), 0.1),
        'r_g2': nrm(20, (DEPTH, R_GATE_LORA, GROUP_WIDTH), R_GATE_LORA ** -0.5),
        'r_kk': gain(21, (DEPTH, GROUP_WIDTH)),
        'r_ka': gain(22, (DEPTH, GROUP_WIDTH)),
        'r_rk': nrm(23, (DEPTH, GROUP_WIDTH), 0.1),
        'r_gn_g': gain(24, (DEPTH, GROUP_WIDTH)),
        'r_gn_b': nrm(25, (DEPTH, GROUP_WIDTH), 0.02),
        'mlp_norm_g': gain(26, (DEPTH, D_MODEL)),
        'w_up': nrm(27, (DEPTH, D_MODEL, D_FF), D_MODEL ** -0.5),
        'w_down': nrm(28, (DEPTH, D_FF, D_MODEL), D_FF ** -0.5),
        'ple_norm_g': gain(29, (DEPTH, D_MODEL)),
        'w_ple': nrm(30, (DEPTH, PLE_DIM, D_MODEL), PLE_DIM ** -0.5),
        'w_ple_gate': nrm(31, (DEPTH, D_MODEL, D_MODEL), D_MODEL ** -0.5),
    }


def reference(x, p, mix_norm_g, w_in, w_out, rel_bias, a_qnorm, a_knorm, a_lambda, a_subln,
              h_lb_logits, h_onorm, c_w, c_b, c_scale, r_mu, r_w0, r_w2, r_a0, r_a2, r_g2,
              r_kk, r_ka, r_rk, r_gn_g, r_gn_b, mlp_norm_g, w_up, w_down, ple_norm_g, w_ple, w_ple_gate):
    lb_cum = jnp.cumsum(jax.nn.softmax(h_lb_logits.astype(jnp.float32), axis=0), axis=0)
    lbs = lb_cum - lb_cum[0:1]
    h = x
    for i in range(DEPTH):
        u = rmsnorm(h, mix_norm_g[i])
        z = u @ w_in[i]
        za, zh, zc, zr = split_last(z, GROUP_SPLITS)
        o_a = diff_attention(za, rel_bias, a_qnorm[i], a_knorm[i], a_lambda[i], a_subln[i], i)
        o_b = hgrn2(zh, lbs[i], h_onorm[i])
        o_c = pool_mixer(zc, c_w[i], c_b[i], c_scale[i])
        o_d = rwkv7(zr, r_mu[i], r_w0[i], r_w2[i], r_a0[i], r_a2[i], r_g2[i], r_kk[i], r_ka[i], r_rk[i], r_gn_g[i], r_gn_b[i])
        mix = jnp.concatenate([o_a.astype(h.dtype), o_b.astype(h.dtype), o_c.astype(h.dtype), o_d.astype(h.dtype)], axis=-1)
        h = h + mix @ w_out[i]
        u = rmsnorm(h, mlp_norm_g[i])
        h = h + jnp.square(jax.nn.relu(u @ w_up[i])) @ w_down[i]
        gate = jax.nn.sigmoid((rmsnorm(h, ple_norm_g[i]) @ w_ple_gate[i]).astype(jnp.float32))
        h = h + ((p[i] @ w_ple[i]).astype(jnp.float32) * gate).astype(h.dtype)
    return h
```

```cpp
#include <hip/hip_runtime.h>
#include <hip/hip_cooperative_groups.h>
#include <cstdio>
namespace cg = cooperative_groups;
typedef unsigned short u16;
typedef short s16x4 __attribute__((ext_vector_type(4)));
typedef float f32x16 __attribute__((ext_vector_type(16)));
typedef unsigned u32x4 __attribute__((ext_vector_type(4)));
typedef unsigned u32x2 __attribute__((ext_vector_type(2)));
#define LAS __attribute__((address_space(3)))

constexpr int T_TOK = 16384, SEQ = 8192, DM = 2048, NIN = 6528, NINP = 6656, DFF = 8192;
constexpr float LOG2E = 1.4426950408889634f;

__device__ __forceinline__ u16 f2bf(float f) { unsigned u = __float_as_uint(f); u += 0x7FFFu + ((u >> 16) & 1u); return (u16)(u >> 16); }
__device__ __forceinline__ float bf2f(u16 b) { return __uint_as_float(((unsigned)b) << 16); }
typedef __bf16 bf2_t __attribute__((ext_vector_type(2)));
__device__ __forceinline__ unsigned pack2(float lo, float hi) { bf2_t v; v[0] = (__bf16)lo; v[1] = (__bf16)hi; return __builtin_bit_cast(unsigned, v); }
__device__ __forceinline__ float bflo(unsigned v) { return __uint_as_float(v << 16); }
__device__ __forceinline__ float bfhi(unsigned v) { return __uint_as_float(v & 0xffff0000u); }
__device__ __forceinline__ float sigmoidf_(float x) { return 1.0f / (1.0f + __expf(-x)); }
template <int CTRL> __device__ __forceinline__ float dppmov(float v) {
    return __builtin_bit_cast(float, __builtin_amdgcn_update_dpp(0, __builtin_bit_cast(int, v), CTRL, 0xF, 0xF, true));
}
__device__ __forceinline__ float swz16(float v) { return __builtin_bit_cast(float, __builtin_amdgcn_ds_swizzle(__builtin_bit_cast(int, v), 0x401F)); }
__device__ __forceinline__ float sum32(float v) {
    const unsigned u = __builtin_bit_cast(unsigned, v);
    auto r = __builtin_amdgcn_permlane32_swap(u, u, false, false);
    return __builtin_bit_cast(float, (unsigned)r[0]) + __builtin_bit_cast(float, (unsigned)r[1]);
}
__device__ __forceinline__ float max32(float v) {
    const unsigned u = __builtin_bit_cast(unsigned, v);
    auto r = __builtin_amdgcn_permlane32_swap(u, u, false, false);
    return fmaxf(__builtin_bit_cast(float, (unsigned)r[0]), __builtin_bit_cast(float, (unsigned)r[1]));
}
__device__ __forceinline__ float allreduce16(float v) {
    v += dppmov<0xB1>(v); v += dppmov<0x4E>(v); v += dppmov<0x141>(v); v += dppmov<0x140>(v); return v;
}
__device__ __forceinline__ float wave_sum(float v) { v = allreduce16(v); v += swz16(v); return sum32(v); }
__device__ __forceinline__ float wave_max(float v) {
    v = fmaxf(v, dppmov<0xB1>(v)); v = fmaxf(v, dppmov<0x4E>(v)); v = fmaxf(v, dppmov<0x141>(v)); v = fmaxf(v, dppmov<0x140>(v));
    v = fmaxf(v, swz16(v)); return max32(v);
}

__device__ __forceinline__ int otid_(int wv) { unsigned zz = 0u; asm volatile("" : "+v"(zz)); int t = wv * 64 + (int)__builtin_amdgcn_mbcnt_hi(~0u, __builtin_amdgcn_mbcnt_lo(~0u, zz)); return t; }
#define otid() otid_(wv)

struct Params {
    const float *x, *p, *mix_norm_g, *w_in, *w_out, *rel_bias, *a_qnorm, *a_knorm, *a_lambda, *a_subln, *h_lb, *h_onorm, *c_w, *c_b, *c_scale,
        *r_mu, *r_w0, *r_w2, *r_a0, *r_a2, *r_g2, *r_kk, *r_ka, *r_rk, *r_gn_g, *r_gn_b, *mlp_norm_g, *w_up, *w_down, *ple_norm_g, *w_ple, *w_gate;
    float* out;
    u16 *R0, *mix, *hb0, *Wt_in, *Wt_out, *Wt_up, *Wt_down, *Wt_gate, *Wt_ple, *pb, *ob, *yb, *qmb;
    _Float16* ra[9];
    float *hv;
    float *ss0, *ss1;
    unsigned* ctr;
};
typedef const __attribute__((address_space(4))) Params* PC;

namespace pg8 {
#define PG8_LAS __attribute__((address_space(3)))
typedef unsigned short bf16_t;
typedef short bf16x8 __attribute__((ext_vector_type(8)));
typedef float f32x4 __attribute__((ext_vector_type(4)));
constexpr int BM = 256, BK = 64, HALF = 128, HTB = HALF * BK * 2  , STAGE_BYTES = 8 * HTB, NXCD = 8, WGM = 8;

__host__ __device__ __forceinline__ int lds_byte(int r, int c) { const int st = (r >> 4) * 2 + (c >> 5), rr = r & 15, cc = c & 31, ob = rr * 64 + cc * 2; return st * 1024 + (ob ^ (((ob >> 9) & 1) << 5)); }
__host__ __device__ __forceinline__ void stage_rc(int b, int& R, int& C) { const int st = b / 1024, sb = b % 1024, swz = sb ^ (((sb >> 9) & 1) << 5); R = (st >> 1) * 16 + swz / 64; C = (st & 1) * 32 + (swz % 64) / 2; }
__host__ __device__ __forceinline__ int perm32(int rho) { const int n = rho >> 4, i = rho & 15; return 8 * (i >> 2) + 4 * n + (i & 3); }

struct Unit { int pm, pn; };
struct Gemm { const bf16_t* A; const bf16_t* Bt; int M, N, K; };

struct StaticOrder {
    int nM, nN, nwg, G, c;
    __host__ __device__ void init(int M, int N, int G_, int c_) { nM = M / BM; nN = N / BM; nwg = nM * nN; G = G_; c = c_; }
    __host__ __device__ bool next(int i, Unit& u) const {
        const long L = (long)i * G + c; if (L >= nwg) return false;
        int wgid = (int)L; { const int q = nwg / NXCD, r = nwg % NXCD, xcd = wgid % NXCD, off = wgid / NXCD; wgid = (xcd < r ? xcd * (q + 1) : r * (q + 1) + (xcd - r) * q) + off; }
        const int nig = WGM * nN, gid = wgid / nig, fm = gid * WGM, gsz = (nM - fm) < WGM ? (nM - fm) : WGM;
        u.pm = fm + ((wgid % nig) % gsz); u.pn = (wgid % nig) / gsz; return true;
    }
    __device__ __forceinline__ void a_ready(const Unit&) const {}
    __device__ __forceinline__ void done(const Unit&) const {}
};
template <class Epi, class Sched>
__device__ __forceinline__ void gemm_phase(int wv, PG8_LAS unsigned char* lds, const Gemm g, const Sched& S, const Epi& E) {
    const int tid = otid(), wid = __builtin_amdgcn_readfirstlane(tid >> 6), lane = tid & 63, wr = wid >> 2, wc = wid & 3, fr = lane & 15, fq = lane >> 4;
    const int K = g.K, nt = K / BK;
    unsigned voffA[2], voffB[2];
#pragma unroll
    for (int i = 0; i < 2; ++i) { int R, C; stage_rc(tid * 16 + i * 8192, R, C); const int Rb = Epi::PERM ? ((R & ~31) + perm32(R & 31)) : R;
        voffA[i] = (unsigned)(R * K + C) * 2u; voffB[i] = (unsigned)(Rb * K + C) * 2u; }
    const size_t kstep = (size_t)(BK * 2);
    const size_t hstep = (size_t)HALF * K * 2;
    const size_t tstep = 2 * hstep;
    const unsigned ldsw = (unsigned)wid * 1024u;
    const int aoff = lds_byte(wr * 64 + fr, fq * 8), boff = lds_byte(wc * 32 + fr, fq * 8);
#define PG8_SA(b, h) (((b) * 2 + (h)) * HTB)
#define PG8_SB(b, h) ((4 + (b) * 2 + (h)) * HTB)
#define PG8_STAGE(bufoff, gbase, voff) do { _Pragma("unroll") for (int _i = 0; _i < 2; ++_i) \
        __builtin_amdgcn_global_load_lds((const unsigned*)((const char*)(gbase) + (voff)[_i]), (PG8_LAS unsigned*)(lds + (bufoff) + ldsw + _i * 8192), 16, 0, 0); } while (0)
#define PG8_LDA(dst, b, h) do { _Pragma("unroll") for (int m = 0; m < 4; ++m) _Pragma("unroll") for (int k = 0; k < 2; ++k) dst[m][k] = *(const PG8_LAS bf16x8*)(lds + PG8_SA(b, h) + aoff + m * 2048 + k * 1024); } while (0)
#define PG8_LDB(dst, b, h) do { _Pragma("unroll") for (int n = 0; n < 2; ++n) _Pragma("unroll") for (int k = 0; k < 2; ++k) dst[n][k] = *(const PG8_LAS bf16x8*)(lds + PG8_SB(b, h) + boff + n * 2048 + k * 1024); } while (0)
#define PG8_MMA(ai, bj, At, Bt) do { __builtin_amdgcn_s_setprio(1); _Pragma("unroll") for (int m = 0; m < 4; ++m) _Pragma("unroll") for (int n = 0; n < 2; ++n) _Pragma("unroll") for (int k = 0; k < 2; ++k) \
        acc[ai][bj][m][n] = __builtin_amdgcn_mfma_f32_16x16x32_bf16(Bt[n][k], At[m][k], acc[ai][bj][m][n], 0, 0, 0); __builtin_amdgcn_s_setprio(0); } while (0)
#define PG8_WAIT_V(n) asm volatile("s_waitcnt vmcnt(" #n ")" ::: "memory")
#define PG8_WAIT_L(n) asm volatile("s_waitcnt lgkmcnt(" #n ")" ::: "memory")
#define PG8_BAR __builtin_amdgcn_s_barrier()
#define PG8_SCHED __builtin_amdgcn_sched_barrier(0)
    Unit cur, nxt; int ui = 0;
    if (!S.next(0, cur)) return;
    f32x4 acc[2][2][4][2];
#pragma unroll
    for (int a = 0; a < 2; ++a)
#pragma unroll
        for (int b = 0; b < 2; ++b)
#pragma unroll
            for (int m = 0; m < 4; ++m)
#pragma unroll
                for (int n = 0; n < 2; ++n) acc[a][b][m][n] = (f32x4){0.f, 0.f, 0.f, 0.f};
    bf16x8 At[4][2], B0[2][2], B1[2][2];
    const char* cA = (const char*)g.A + (size_t)cur.pm * tstep; const char* cB = (const char*)g.Bt + (size_t)cur.pn * tstep;
    S.a_ready(cur);
    PG8_STAGE(PG8_SB(0, 0), cB, voffB); PG8_STAGE(PG8_SA(0, 0), cA, voffA); PG8_STAGE(PG8_SB(0, 1), cB + hstep, voffB); PG8_STAGE(PG8_SA(0, 1), cA + hstep, voffA);
    if (wr == 1) PG8_BAR;
    PG8_WAIT_V(4); PG8_BAR;
    PG8_STAGE(PG8_SB(1, 0), cB + kstep, voffB); PG8_STAGE(PG8_SA(1, 0), cA + kstep, voffA); PG8_STAGE(PG8_SB(1, 1), cB + hstep + kstep, voffB);
    PG8_WAIT_V(6); PG8_BAR;
    for (;;) {
        const bool has_next = S.next(ui + 1, nxt);
        const char* nA = has_next ? (const char*)g.A + (size_t)nxt.pm * tstep : cA; const char* nB = has_next ? (const char*)g.Bt + (size_t)nxt.pn * tstep : cB;
        for (int t = 0; t < nt; t += 2) {
            const bool last = (t == nt - 2);
            const char* a1 = cA + (size_t)(t + 1) * kstep;
            const char* a2 = last ? nA : cA + (size_t)(t + 2) * kstep; const char* b2 = last ? nB : cB + (size_t)(t + 2) * kstep;
            const char* a3 = a2 + kstep; const char* b3 = b2 + kstep;
            if (last && has_next) S.a_ready(nxt);
            PG8_LDB(B0, 0, 0); PG8_SCHED; PG8_LDA(At, 0, 0); PG8_STAGE(PG8_SA(1, 1), a1 + hstep, voffA);
            PG8_WAIT_L(8); PG8_BAR; PG8_WAIT_L(0); PG8_MMA(0, 0, At, B0); PG8_BAR; PG8_SCHED;
            PG8_LDB(B1, 0, 1); PG8_STAGE(PG8_SB(0, 0), b2, voffB);
            PG8_BAR; PG8_WAIT_L(0); PG8_MMA(0, 1, At, B1); PG8_BAR;
            PG8_LDA(At, 0, 1); PG8_STAGE(PG8_SA(0, 0), a2, voffA);
            PG8_BAR; PG8_WAIT_L(0); PG8_MMA(1, 0, At, B0); PG8_BAR; PG8_SCHED;
            PG8_STAGE(PG8_SB(0, 1), b2 + hstep, voffB);
            PG8_WAIT_V(6); PG8_BAR; PG8_MMA(1, 1, At, B1); PG8_BAR;
            PG8_LDB(B0, 1, 0); PG8_SCHED; PG8_LDA(At, 1, 0); PG8_STAGE(PG8_SA(0, 1), a2 + hstep, voffA);
            PG8_WAIT_L(8); PG8_BAR; PG8_WAIT_L(0); PG8_MMA(0, 0, At, B0); PG8_BAR; PG8_SCHED;
            PG8_LDB(B1, 1, 1); PG8_STAGE(PG8_SB(1, 0), b3, voffB);
            PG8_BAR; PG8_WAIT_L(0); PG8_MMA(0, 1, At, B1); PG8_BAR;
            PG8_LDA(At, 1, 1); PG8_STAGE(PG8_SA(1, 0), a3, voffA);
            PG8_BAR; PG8_WAIT_L(0); PG8_MMA(1, 0, At, B0); PG8_BAR; PG8_SCHED;
            PG8_STAGE(PG8_SB(1, 1), b3 + hstep, voffB);
            PG8_WAIT_V(6); PG8_BAR; PG8_MMA(1, 1, At, B1); PG8_BAR;
        }
        if constexpr (!Epi::AFTER_DRAIN) { E(acc, cur, wr, wc, fr, fq); S.done(cur); }
        if (!has_next) break;
#pragma unroll
        for (int a = 0; a < 2; ++a)
#pragma unroll
            for (int b = 0; b < 2; ++b)
#pragma unroll
                for (int m = 0; m < 4; ++m)
#pragma unroll
                    for (int n = 0; n < 2; ++n) acc[a][b][m][n] = (f32x4){0.f, 0.f, 0.f, 0.f};
        cur = nxt; cA = nA; cB = nB; ++ui;
    }
    PG8_WAIT_V(0);
    if (wr == 0) PG8_BAR;
    PG8_BAR;
    if constexpr (Epi::AFTER_DRAIN) { E.fused(acc, cur, wr, wc, fr, fq, lds, wid, lane); S.done(cur); }
#undef PG8_SA
#undef PG8_SB
#undef PG8_STAGE
#undef PG8_LDA
#undef PG8_LDB
#undef PG8_MMA
#undef PG8_WAIT_V
#undef PG8_WAIT_L
#undef PG8_BAR
#undef PG8_SCHED
}
}
using pg8::f32x4; using pg8::bf16x8; using pg8::Unit;

__device__ __forceinline__ void load_rinv(const float* ss, int row0, int fq, float (&rinv)[2][4]) {
#pragma unroll
    for (int ai = 0; ai < 2; ++ai)
#pragma unroll
        for (int m = 0; m < 4; ++m) {
            const int row = row0 + ai * 128 + m * 16;
            const f32x4* q = (const f32x4*)(ss + (size_t)row * 32 + fq * 8);
            const f32x4 a = q[0], b = q[1];
            float s = (a[0] + a[1]) + (a[2] + a[3]) + (b[0] + b[1]) + (b[2] + b[3]);
            s += swz16(s); s = sum32(s);
            rinv[ai][m] = rsqrtf(s * (1.0f / 2048.0f) + 1e-6f);
        }
}
struct EpiZ {
    static constexpr bool PERM = true, AFTER_DRAIN = false;
    u16* Z; const float* ss;
    __device__ __forceinline__ void operator()(const f32x4 (&acc)[2][2][4][2], const Unit& u, int wr, int wc, int fr, int fq) const {
        const int row0 = u.pm * 256 + wr * 64 + fr, col0 = u.pn * 256 + wc * 32 + 8 * fq;
        float rinv[2][4]; load_rinv(ss, row0, fq, rinv);
#pragma unroll
        for (int ai = 0; ai < 2; ++ai)
#pragma unroll
            for (int m = 0; m < 4; ++m) {
                const int row = row0 + ai * 128 + m * 16; const float ri = rinv[ai][m];
#pragma unroll
                for (int bj = 0; bj < 2; ++bj) {
                    const int c0 = col0 + bj * 128;
                    if (c0 < NIN) {
                        const f32x4 v0 = acc[ai][bj][m][0] * ri, v1 = acc[ai][bj][m][1] * ri;
                        u32x4 o; o.x = pack2(v0[0], v0[1]); o.y = pack2(v0[2], v0[3]); o.z = pack2(v1[0], v1[1]); o.w = pack2(v1[2], v1[3]);
                        *(u32x4*)(Z + (size_t)row * NIN + c0) = o;
                    }
                }
            }
    }
};
struct EpiUp {
    static constexpr bool PERM = true, AFTER_DRAIN = false;
    u16* H; const float* ss;
    __device__ __forceinline__ void operator()(const f32x4 (&acc)[2][2][4][2], const Unit& u, int wr, int wc, int fr, int fq) const {
        const int row0 = u.pm * 256 + wr * 64 + fr, col0 = u.pn * 256 + wc * 32 + 8 * fq;
        float rinv[2][4]; load_rinv(ss, row0, fq, rinv);
#pragma unroll
        for (int ai = 0; ai < 2; ++ai)
#pragma unroll
            for (int m = 0; m < 4; ++m) {
                const int row = row0 + ai * 128 + m * 16; const float ri = rinv[ai][m];
#pragma unroll
                for (int bj = 0; bj < 2; ++bj) {
                    const int c0 = col0 + bj * 128;
                    float v[8];
#pragma unroll
                    for (int e = 0; e < 4; ++e) { float a = fmaxf(acc[ai][bj][m][0][e] * ri, 0.f), b = fmaxf(acc[ai][bj][m][1][e] * ri, 0.f); v[e] = a * a; v[4 + e] = b * b; }
                    u32x4 o; o.x = pack2(v[0], v[1]); o.y = pack2(v[2], v[3]); o.z = pack2(v[4], v[5]); o.w = pack2(v[6], v[7]);
                    *(u32x4*)(H + (size_t)row * DFF + c0) = o;
                }
            }
    }
};
struct EpiPl {
    static constexpr bool PERM = true, AFTER_DRAIN = false;
    u16* PL;
    __device__ __forceinline__ void operator()(const f32x4 (&acc)[2][2][4][2], const Unit& u, int wr, int wc, int fr, int fq) const {
        const int row0 = u.pm * 256 + wr * 64 + fr, col0 = u.pn * 256 + wc * 32 + 8 * fq;
#pragma unroll
        for (int ai = 0; ai < 2; ++ai)
#pragma unroll
            for (int m = 0; m < 4; ++m) {
                const int row = row0 + ai * 128 + m * 16;
#pragma unroll
                for (int bj = 0; bj < 2; ++bj) {
                    const int c0 = col0 + bj * 128;
                    const f32x4 v0 = acc[ai][bj][m][0], v1 = acc[ai][bj][m][1];
                    u32x4 o; o.x = pack2(v0[0], v0[1]); o.y = pack2(v0[2], v0[3]); o.z = pack2(v1[0], v1[1]); o.w = pack2(v1[2], v1[3]);
                    *(u32x4*)(PL + (size_t)row * DM + c0) = o;
                }
            }
    }
};
struct EpiRes {
    static constexpr bool PERM = true, AFTER_DRAIN = false;
    const float* res; float* out; u16* hb; float* ss_out;
    __device__ __forceinline__ void operator()(const f32x4 (&acc)[2][2][4][2], const Unit& u, int wr, int wc, int fr, int fq) const {
        const int row0 = u.pm * 256 + wr * 64 + fr, col0 = u.pn * 256 + wc * 32 + 8 * fq;
#pragma unroll
        for (int ai = 0; ai < 2; ++ai)
#pragma unroll
            for (int m = 0; m < 4; ++m) {
                const int row = row0 + ai * 128 + m * 16; float sq = 0.f;
#pragma unroll
                for (int bj = 0; bj < 2; ++bj) {
                    const size_t off = (size_t)row * DM + col0 + bj * 128;
                    const f32x4 r0 = *(const f32x4*)(res + off), r1 = *(const f32x4*)(res + off + 4);
                    const f32x4 v0 = acc[ai][bj][m][0] + r0, v1 = acc[ai][bj][m][1] + r1;
                    *(f32x4*)(out + off) = v0; *(f32x4*)(out + off + 4) = v1;
                    u32x4 o; o.x = pack2(v0[0], v0[1]); o.y = pack2(v0[2], v0[3]); o.z = pack2(v1[0], v1[1]); o.w = pack2(v1[2], v1[3]);
                    *(u32x4*)(hb + off) = o;
                    sq += v0[0] * v0[0] + v0[1] * v0[1] + v0[2] * v0[2] + v0[3] * v0[3] + v1[0] * v1[0] + v1[1] * v1[1] + v1[2] * v1[2] + v1[3] * v1[3];
                }
                sq += swz16(sq); sq = sum32(sq);
                if (fq == 0) ss_out[(size_t)row * 32 + u.pn * 4 + wc] = sq;
            }
    }
};
template <bool LAST> struct EpiGate {
    static constexpr bool PERM = true, AFTER_DRAIN = false;
    const u16* PL; float* out; u16* hb; const float* ss; float* ss_out;
    __device__ __forceinline__ void operator()(const f32x4 (&acc)[2][2][4][2], const Unit& u, int wr, int wc, int fr, int fq) const {
        const int row0 = u.pm * 256 + wr * 64 + fr, col0 = u.pn * 256 + wc * 32 + 8 * fq;
        float rinv[2][4]; load_rinv(ss, row0, fq, rinv);
#pragma unroll
        for (int ai = 0; ai < 2; ++ai)
#pragma unroll
            for (int m = 0; m < 4; ++m) {
                const int row = row0 + ai * 128 + m * 16; const float ri = rinv[ai][m]; float sq = 0.f;
#pragma unroll
                for (int bj = 0; bj < 2; ++bj) {
                    const size_t off = (size_t)row * DM + col0 + bj * 128;
                    const f32x4 h0 = *(const f32x4*)(out + off), h1 = *(const f32x4*)(out + off + 4);
                    const u32x4 pv = *(const u32x4*)(PL + off);
                    const float pl[8] = {bflo(pv.x), bfhi(pv.x), bflo(pv.y), bfhi(pv.y), bflo(pv.z), bfhi(pv.z), bflo(pv.w), bfhi(pv.w)};
                    f32x4 v0, v1;
#pragma unroll
                    for (int e = 0; e < 4; ++e) {
                        v0[e] = h0[e] + pl[e] * sigmoidf_(acc[ai][bj][m][0][e] * ri);
                        v1[e] = h1[e] + pl[4 + e] * sigmoidf_(acc[ai][bj][m][1][e] * ri);
                    }
                    *(f32x4*)(out + off) = v0; *(f32x4*)(out + off + 4) = v1;
                    u32x4 o; o.x = pack2(v0[0], v0[1]); o.y = pack2(v0[2], v0[3]); o.z = pack2(v1[0], v1[1]); o.w = pack2(v1[2], v1[3]);
                    if (!LAST) *(u32x4*)(hb + off) = o;
                    sq += v0[0] * v0[0] + v0[1] * v0[1] + v0[2] * v0[2] + v0[3] * v0[3] + v1[0] * v1[0] + v1[1] * v1[1] + v1[2] * v1[2] + v1[3] * v1[3];
                }
                sq += swz16(sq); sq = sum32(sq);
                if (!LAST && fq == 0) ss_out[(size_t)row * 32 + u.pn * 4 + wc] = sq;
            }
    }
};
template <class Epi> __device__ __forceinline__ void run_gemm(int wv, LAS unsigned char* lds, const u16* A, const u16* Bt, int M, int N, int K, const Epi& E) {
    pg8::Gemm g; g.A = A; g.Bt = Bt; g.M = M; g.N = N; g.K = K;
    pg8::StaticOrder S; S.init(M, N, (int)gridDim.x, (int)blockIdx.x);
    pg8::gemm_phase<Epi, pg8::StaticOrder>(wv, lds, g, S, E);
}

__device__ __forceinline__ void conv_tile(int wv, const float* src, int K, int N, const float* gs, u16* dst, int k0, int n0, LAS u16* T) {
    const int tid = otid();
    {
        const int r = tid >> 4, c4 = (tid & 15) * 4;
#pragma unroll
        for (int ps = 0; ps < 2; ++ps) {
            const int k = k0 + r + 32 * ps;
            const float4 v = *(const float4*)(src + (size_t)k * N + n0 + c4);
            const float g = gs ? gs[k] : 1.0f;
            T[(c4 + 0) * 66 + r + 32 * ps] = f2bf(v.x * g); T[(c4 + 1) * 66 + r + 32 * ps] = f2bf(v.y * g);
            T[(c4 + 2) * 66 + r + 32 * ps] = f2bf(v.z * g); T[(c4 + 3) * 66 + r + 32 * ps] = f2bf(v.w * g);
        }
    }
    __syncthreads();
    {
        const int n = tid >> 3, kc = (tid & 7) * 8;
        const LAS unsigned* s = (const LAS unsigned*)(T + n * 66 + kc);
        u32x4 o; o.x = s[0]; o.y = s[1]; o.z = s[2]; o.w = s[3];
        *(u32x4*)(dst + (size_t)(n0 + n) * K + k0 + kc) = o;
    }
    __syncthreads();
}
struct ConvTD { const float* src; const float* gs; u16* dst; int K, N, k0, n0; };
template <class Dec> __device__ __forceinline__ void conv_stream(int wv, int first, int count, int stride, LAS u16* T, Dec dec) {
    const int tid = otid();
    const int r = tid >> 4, c4 = (tid & 15) * 4, n = tid >> 3, kc = (tid & 7) * 8;
    int it = first;
    if (it < count) {
        ConvTD cur = dec(it);
        f32x4 v0 = __builtin_nontemporal_load((const f32x4*)(cur.src + (size_t)(cur.k0 + r) * cur.N + cur.n0 + c4)), v1 = __builtin_nontemporal_load((const f32x4*)(cur.src + (size_t)(cur.k0 + r + 32) * cur.N + cur.n0 + c4));
        float g0 = cur.gs ? cur.gs[cur.k0 + r] : 1.0f, g1 = cur.gs ? cur.gs[cur.k0 + r + 32] : 1.0f;
        int par = 0;
        for (;;) {
            LAS u16* Tb = T + par * 4224;
            Tb[(c4 + 0) * 66 + r] = f2bf(v0.x * g0); Tb[(c4 + 1) * 66 + r] = f2bf(v0.y * g0); Tb[(c4 + 2) * 66 + r] = f2bf(v0.z * g0); Tb[(c4 + 3) * 66 + r] = f2bf(v0.w * g0);
            Tb[(c4 + 0) * 66 + r + 32] = f2bf(v1.x * g1); Tb[(c4 + 1) * 66 + r + 32] = f2bf(v1.y * g1); Tb[(c4 + 2) * 66 + r + 32] = f2bf(v1.z * g1); Tb[(c4 + 3) * 66 + r + 32] = f2bf(v1.w * g1);
            const int nx = it + stride; const bool has = nx < count;
            ConvTD nd = cur;
            if (has) {
                nd = dec(nx);
                v0 = __builtin_nontemporal_load((const f32x4*)(nd.src + (size_t)(nd.k0 + r) * nd.N + nd.n0 + c4)); v1 = __builtin_nontemporal_load((const f32x4*)(nd.src + (size_t)(nd.k0 + r + 32) * nd.N + nd.n0 + c4));
                g0 = nd.gs ? nd.gs[nd.k0 + r] : 1.0f; g1 = nd.gs ? nd.gs[nd.k0 + r + 32] : 1.0f;
            }
            __syncthreads();
            {
                const LAS unsigned* sp = (const LAS unsigned*)(Tb + n * 66 + kc);
                u32x4 o; o.x = sp[0]; o.y = sp[1]; o.z = sp[2]; o.w = sp[3];
                *(u32x4*)(cur.dst + (size_t)(cur.n0 + n) * cur.K + cur.k0 + kc) = o;
            }
            if (!has) break;
            cur = nd; it = nx; par ^= 1;
        }
    }
    __syncthreads();
}
__device__ __forceinline__ void phase_conv(PC p, int wv, int L, LAS unsigned char* lds, int part) {
    LAS u16* T = (LAS u16*)lds;
    const int tid = otid();
    if (part == 1) {
        conv_stream(wv, (int)blockIdx.x, 9344, (int)gridDim.x, T, [&](int it) {
            ConvTD d; int id;
            if (it < 4096) { id = it; d.src = p->w_up + (size_t)L * DM * DFF; d.K = DM; d.N = DFF; d.gs = p->mlp_norm_g + L * DM; d.dst = p->Wt_up; }
            else if (it < 8192) { id = it - 4096; d.src = p->w_down + (size_t)L * DFF * DM; d.K = DFF; d.N = DM; d.gs = nullptr; d.dst = p->Wt_down; }
            else if (it < 9216) { id = it - 8192; d.src = p->w_gate + (size_t)L * DM * DM; d.K = DM; d.N = DM; d.gs = p->ple_norm_g + L * DM; d.dst = p->Wt_gate; }
            else { id = it - 9216; d.src = p->w_ple + (size_t)L * 256 * DM; d.K = 256; d.N = DM; d.gs = nullptr; d.dst = p->Wt_ple; }
            const int ntn = d.N / 64; d.k0 = (id / ntn) * 64; d.n0 = (id % ntn) * 64;
            return d; });
        return;
    }
    const int nW = 4288, nPad = 64, nP = 1024, nX = (L == 0) ? 2048 : 0;
    conv_stream(wv, (int)blockIdx.x, nW, (int)gridDim.x, T, [&](int it) {
        ConvTD d; int id;
        if (it < 3264) { id = it; d.src = p->w_in + (size_t)L * DM * NIN; d.K = DM; d.N = NIN; d.gs = p->mix_norm_g + L * DM; d.dst = p->Wt_in; }
        else { id = it - 3264; d.src = p->w_out + (size_t)L * DM * DM; d.K = DM; d.N = DM; d.gs = nullptr; d.dst = p->Wt_out; }
        const int ntn = d.N / 64; d.k0 = (id / ntn) * 64; d.n0 = (id % ntn) * 64;
        return d; });
    const int total = nW + nPad + nP + nX;
    for (int it = nW + blockIdx.x; it < total; it += gridDim.x) {
        if (it < nW + nPad) {
            const int i = (it - nW) * 512 + tid;
            u32x4 zz; zz.x = zz.y = zz.z = zz.w = 0u;
            ((u32x4*)(p->Wt_in + (size_t)NIN * DM))[i] = zz;
        } else if (it < nW + nPad + nP) {
            const size_t i = ((size_t)(it - nW - nPad) * 512 + tid) * 8;
            const float* s = p->p + (size_t)L * T_TOK * 256 + i;
            const float4 a = *(const float4*)s, b = *(const float4*)(s + 4);
            u32x4 o; o.x = pack2(a.x, a.y); o.y = pack2(a.z, a.w); o.z = pack2(b.x, b.y); o.w = pack2(b.z, b.w);
            *(u32x4*)(p->pb + i) = o;
        } else {
            const int row = (it - nW - nPad - nP) * 8 + (tid >> 6), lane = tid & 63;
            const float* s = p->x + (size_t)row * DM; u16* d = p->mix + (size_t)row * DM;
            float sq = 0.f;
#pragma unroll
            for (int i = 0; i < 8; ++i) {
                const float4 v = *(const float4*)(s + (i * 64 + lane) * 4);
                sq += v.x * v.x + v.y * v.y + v.z * v.z + v.w * v.w;
                u32x2 o; o.x = pack2(v.x, v.y); o.y = pack2(v.z, v.w);
                *(u32x2*)(d + (i * 64 + lane) * 4) = o;
            }
            sq = wave_sum(sq);
            if (lane < 32) p->ss0[(size_t)row * 32 + lane] = (lane == 0) ? sq : 0.f;
        }
    }
}
__device__ __forceinline__ f32x16 mfma32(bf16x8 a, bf16x8 b, f32x16 c) { return __builtin_amdgcn_mfma_f32_32x32x16_bf16(a, b, c, 0, 0, 0); }
template <int K> __device__ __forceinline__ f32x16 mm32(const LAS unsigned char* act, int pitchB, const float* wcol, int ldw, int j, int g) {
    f32x16 acc;
#pragma unroll
    for (int r = 0; r < 16; ++r) acc[r] = 0.f;
    float wn[8], wc[8];
#pragma unroll
    for (int e = 0; e < 8; ++e) wn[e] = wcol[(size_t)(8 * g + e) * ldw];
#pragma unroll
    for (int ks = 0; ks < K / 16; ++ks) {
#pragma unroll
        for (int e = 0; e < 8; ++e) wc[e] = wn[e];
        if (ks + 1 < K / 16) {
#pragma unroll
            for (int e = 0; e < 8; ++e) wn[e] = wcol[(size_t)(16 * (ks + 1) + 8 * g + e) * ldw];
        }
        const bf16x8 a = *(const LAS bf16x8*)(act + j * pitchB + ks * 32 + g * 16);
        u32x4 q; q.x = pack2(wc[0], wc[1]); q.y = pack2(wc[2], wc[3]); q.z = pack2(wc[4], wc[5]); q.w = pack2(wc[6], wc[7]);
        acc = mfma32(a, __builtin_bit_cast(bf16x8, q), acc);
    }
    return acc;
}
constexpr int ZA = 0, ZH = 1536, ZC = 4096, ZR = 4608;
template <int W> __device__ __forceinline__ void pool_diff(const float (&zw)[47], const bool (&ok)[47], float (&df)[32]) {
#pragma unroll
    for (int t = 0; t < 32; ++t) {
        float s = 0.f, c = 0.f;
#pragma unroll
        for (int o = -(W / 2); o <= (W - W / 2 - 1); ++o) { s += zw[8 + t + o]; c += ok[8 + t + o] ? 1.f : 0.f; }
        df[t] = s / c - zw[8 + t];
    }
}
__device__ __forceinline__ void rwkv_prep_item(PC p, int wv, int L, int tb, LAS unsigned char* lds) {
    const int tid = otid(); const u16* z = p->R0;
    const int tok0 = tb * 32;
    LAS unsigned char* actb = lds;
    LAS float* outL = (LAS float*)(lds + 20480);
    {
        const int t = tid >> 4, c4 = (tid & 15) * 4, tok = tok0 + t, sq = tok & (SEQ - 1);
#pragma unroll
        for (int which = 0; which < 4; ++which) {
            const int rc = 1536 + which * 64 + c4;
            const u16* zc = z + (size_t)tok * NIN + ZR + rc;
            const float* mu0 = p->r_mu + (size_t)L * 3840 + rc; const float* mu1 = mu0 + 1920;
#pragma unroll
            for (int e = 0; e < 4; ++e) {
                const float zt = bf2f(zc[e]);
                const float zp = sq > 0 ? bf2f(zc[e - NIN]) : 0.f, zn = sq < SEQ - 1 ? bf2f(zc[e + NIN]) : 0.f;
                float v = zt + mu0[e] * (zp - zt) + mu1[e] * (zn - zt);
                if (which < 2) v = tanhf(v);
                *(LAS u16*)(actb + which * 4608 + t * 144 + (c4 + e) * 2) = f2bf(v);
            }
        }
    }
    __syncthreads();
    const int col = tid;
    float kk_[32], k_[32];
    {
        const float mu0r = p->r_mu[(size_t)L * 3840 + col], mu1r = p->r_mu[(size_t)L * 3840 + 1920 + col];
        const float mu0k = p->r_mu[(size_t)L * 3840 + 512 + col], mu1k = p->r_mu[(size_t)L * 3840 + 1920 + 512 + col];
        const float mu0v = p->r_mu[(size_t)L * 3840 + 1024 + col], mu1v = p->r_mu[(size_t)L * 3840 + 1920 + 1024 + col];
        const float kkg = p->r_kk[L * 512 + col];
        const int s0 = tok0 & (SEQ - 1);
        const u16* zc = z + (size_t)tok0 * NIN + ZR + col;
        float zr_[34], zk_[34], zv_[34];
#pragma unroll
        for (int i = 0; i < 34; ++i) {
            const int sq = s0 - 1 + i; const bool ok = (sq >= 0) && (sq < SEQ);
            const u16* q = zc + (long)(i - 1) * NIN;
            zr_[i] = ok ? bf2f(q[0]) : 0.f; zk_[i] = ok ? bf2f(q[512]) : 0.f; zv_[i] = ok ? bf2f(q[1024]) : 0.f;
        }
        _Float16* dr = p->ra[0] + (size_t)tok0 * 512 + col; _Float16* dk = p->ra[1] + (size_t)tok0 * 512 + col; _Float16* dv = p->ra[2] + (size_t)tok0 * 512 + col;
#pragma unroll
        for (int t = 0; t < 32; ++t) {
            const float rp = zr_[t], rc = zr_[t + 1], rn = zr_[t + 2];
            const float kp = zk_[t], kc = zk_[t + 1], kn = zk_[t + 2];
            const float vp = zv_[t], vc = zv_[t + 1], vn = zv_[t + 2];
            const float r = rc + mu0r * (rp - rc) + mu1r * (rn - rc);
            const float k = kc + mu0k * (kp - kc) + mu1k * (kn - kc);
            const float v = vc + mu0v * (vp - vc) + mu1v * (vn - vc);
            float kk = k * kkg;
            kk *= rsqrtf(wave_sum(kk * kk) + 1e-12f);
            k_[t] = k; kk_[t] = kk;
            dr[(size_t)t * 512] = (_Float16)r; dk[(size_t)t * 512] = (_Float16)kk; dv[(size_t)t * 512] = (_Float16)v;
        }
    }
    const float kag = p->r_ka[L * 512 + col];
#pragma unroll
    for (int which = 0; which < 4; ++which) {
        const int d = which & 1;
        {
            const int lane = tid & 63, g = lane >> 5, j = lane & 31, wave = tid >> 6;
            const float* Wb = (which < 2 ? p->r_w2 : p->r_a2) + ((size_t)L * 2 + d) * 64 * 512;
#pragma unroll 1
            for (int i = 0; i < 2; ++i) {
                const int n0 = (2 * wave + i) * 32;
                const f32x16 c = mm32<64>(actb + which * 4608, 144, Wb + n0 + j, 512, j, g);
#pragma unroll
                for (int r = 0; r < 16; ++r) outL[((r >> 2) * 8 + 4 * g + (r & 3)) * 512 + n0 + j] = c[r];
            }
        }
        __syncthreads();
        float acc[32];
#pragma unroll
        for (int t = 0; t < 32; ++t) acc[t] = outL[t * 512 + col];
        const float bias = (which < 2 ? p->r_w0 : p->r_a0)[((size_t)L * 2 + d) * 512 + col];
        if (which < 2) {
            _Float16* dw = p->ra[3 + 3 * d] + (size_t)tok0 * 512 + col;
#pragma unroll
            for (int t = 0; t < 32; ++t) dw[(size_t)t * 512] = (_Float16)__expf(-0.6065306597126334f * sigmoidf_(bias + acc[t]));
        } else {
            _Float16* db = p->ra[4 + 3 * d] + (size_t)tok0 * 512 + col; _Float16* de = p->ra[5 + 3 * d] + (size_t)tok0 * 512 + col;
#pragma unroll
            for (int t = 0; t < 32; ++t) {
                const float a = sigmoidf_(bias + acc[t]);
                db[(size_t)t * 512] = (_Float16)(kk_[t] * a);
                de[(size_t)t * 512] = (_Float16)(k_[t] * (1.0f + (a - 1.0f) * kag));
            }
        }
        __syncthreads();
    }
}
__device__ __forceinline__ void phase_prep(PC p, int wv, int L, LAS unsigned char* lds) {
    const int tid = otid();
    u16* z = p->R0;
    const int nQK = 512, nLora = 512, nPool = 512, nHg = 1024;
    const int total = nQK + nLora + nPool + nHg;
    for (int it = blockIdx.x; it < total; it += gridDim.x) {
        if (it < nQK) {
            const int tok = it * 32 + (tid >> 4), grp = tid & 15;
            u16* q = z + (size_t)tok * NIN + grp * 64;
            const float* gn = (grp < 8 ? p->a_qnorm : p->a_knorm) + L * 64;
            const float sc = grp < 8 ? 0.125f * LOG2E : 1.0f;
            u32x4 v[8]; float ss = 0.f;
#pragma unroll
            for (int i = 0; i < 8; ++i) {
                v[i] = ((const u32x4*)q)[i];
                const float a0 = bflo(v[i].x), a1 = bfhi(v[i].x), a2 = bflo(v[i].y), a3 = bfhi(v[i].y), a4 = bflo(v[i].z), a5 = bfhi(v[i].z), a6 = bflo(v[i].w), a7 = bfhi(v[i].w);
                ss += a0 * a0 + a1 * a1 + a2 * a2 + a3 * a3 + a4 * a4 + a5 * a5 + a6 * a6 + a7 * a7;
            }
            const float ri = rsqrtf(ss * (1.0f / 64.0f) + 1e-6f) * sc;
#pragma unroll
            for (int i = 0; i < 8; ++i) {
                const float* g = gn + i * 8;
                u32x4 o;
                o.x = pack2(bflo(v[i].x) * ri * g[0], bfhi(v[i].x) * ri * g[1]); o.y = pack2(bflo(v[i].y) * ri * g[2], bfhi(v[i].y) * ri * g[3]);
                o.z = pack2(bflo(v[i].z) * ri * g[4], bfhi(v[i].z) * ri * g[5]); o.w = pack2(bflo(v[i].w) * ri * g[6], bfhi(v[i].w) * ri * g[7]);
                ((u32x4*)q)[i] = o;
            }
        } else if (it < nQK + nLora) {
            rwkv_prep_item(p, wv, L, it - nQK, lds);
        } else if (it < nQK + nLora + nPool) {
            const int tb = it - nQK - nLora, tok0 = tb * 32, s0 = tok0 & (SEQ - 1);
            LAS unsigned char* dfb = lds;
            {
                float zw[47]; bool ok[47];
                const u16* zc = z + (size_t)tok0 * NIN + ZC + tid;
#pragma unroll
                for (int i = 0; i < 47; ++i) {
                    const int s = s0 - 8 + i; ok[i] = (s >= 0 && s < SEQ);
                    zw[i] = ok[i] ? bf2f(zc[(long)(i - 8) * NIN]) : 0.f;
                }
                float d[32];
                const int gi = tid >> 7;
                if (gi == 0) pool_diff<2>(zw, ok, d); else if (gi == 1) pool_diff<4>(zw, ok, d); else if (gi == 2) pool_diff<8>(zw, ok, d); else pool_diff<16>(zw, ok, d);
#pragma unroll
                for (int t = 0; t < 32; ++t) *(LAS u16*)(dfb + t * 1040 + tid * 2) = f2bf(d[t]);
            }
            __syncthreads();
            {
                const int lane = tid & 63, g = lane >> 5, j = lane & 31, wave = tid >> 6;
#pragma unroll 1
                for (int i = 0; i < 2; ++i) {
                    const int nt = 2 * wave + i, gi = nt >> 2, d0 = (nt & 3) * 32, ccol = gi * 128 + d0 + j;
                    const f32x16 c = mm32<128>(dfb + gi * 256, 1040, p->c_w + ((size_t)L * 4 + gi) * 128 * 128 + d0 + j, 128, j, g);
                    const float cb = p->c_b[L * 512 + ccol], cs = p->c_scale[L * 512 + ccol];
                    u16* dst = p->mix + (size_t)tok0 * DM + 1024 + ccol;
#pragma unroll
                    for (int r = 0; r < 16; ++r) dst[(size_t)((r >> 2) * 8 + 4 * g + (r & 3)) * DM] = f2bf((c[r] + cb) * cs);
                }
            }
            __syncthreads();
        } else {
            const int id = it - nQK - nLora - nPool, h = id & 3, ch = (id >> 2) & 127, b = id >> 9;
            const int d = tid & 127, qtr = tid >> 7;
            const size_t tok0 = (size_t)b * SEQ + ch * 64 + qtr * 16;
            LAS float* tot = (LAS float*)lds;
            float lb = 0.f;
            if (L == 1) lb = 1.0f / (1.0f + __expf(p->h_lb[h * 128 + d] - p->h_lb[512 + h * 128 + d]));
            u16* zq = z + tok0 * NIN + ZH + h * 128 + d;
            float qs[16], kf[16], kb[16], pf[16], pb[16], lbk[16];
            float sf = 0.f, sb = 0.f;
#pragma unroll
            for (int j = 0; j < 16; ++j) {
                const float q = bf2f(zq[(size_t)j * NIN]), ff = bf2f(zq[(size_t)j * NIN + 512]), fb = bf2f(zq[(size_t)j * NIN + 1024]);
                qs[j] = q * sigmoidf_(q);
                const float gf = lb + (1.f - lb) * sigmoidf_(ff), gb = lb + (1.f - lb) * sigmoidf_(fb);
                kf[j] = (1.f - lb) * sigmoidf_(-ff); kb[j] = (1.f - lb) * sigmoidf_(-fb);
                const float lf = __logf(gf), lbw = __logf(gb);
                sf += lf; sb += lbw; pf[j] = sf; pb[j] = sb; lbk[j] = lbw;
            }
            tot[(0 * 4 + qtr) * 128 + d] = sf; tot[(1 * 4 + qtr) * 128 + d] = sb;
            __syncthreads();
            const float tf0 = tot[0 * 128 + d], tf1 = tot[1 * 128 + d], tf2 = tot[2 * 128 + d], tf3 = tot[3 * 128 + d];
            const float tb0 = tot[4 * 128 + d], tb1 = tot[5 * 128 + d], tb2 = tot[6 * 128 + d], tb3 = tot[7 * 128 + d];
            const float offf = (qtr > 0 ? tf0 : 0.f) + (qtr > 1 ? tf1 : 0.f) + (qtr > 2 ? tf2 : 0.f);
            const float offb = (qtr > 0 ? tb0 : 0.f) + (qtr > 1 ? tb1 : 0.f) + (qtr > 2 ? tb2 : 0.f);
            const float bmidf = tf0 + tf1, blastf = bmidf + tf2 + tf3;
            const float totb = tb0 + tb1 + tb2 + tb3, bmidb = tb2 + tb3;
            u16* qb = p->qmb + tok0 * 512 + h * 128 + d;
#pragma unroll
            for (int j = 0; j < 16; ++j) {
                const float bt = offf + pf[j];
                const float bbt = totb - (offb + pb[j]) + lbk[j];
                zq[(size_t)j * NIN] = f2bf(qs[j] * __expf(bt - bmidf));
                zq[(size_t)j * NIN + 512] = f2bf(kf[j] * __expf(bmidf - bt));
                zq[(size_t)j * NIN + 1024] = f2bf(kb[j] * __expf(bmidb - bbt));
                qb[(size_t)j * 512] = f2bf(qs[j] * __expf(bbt - bmidb));
            }
            if (qtr == 0) {
                float* hvf = p->hv + ((((size_t)0 * 2 + b) * 128 + ch) * 4 + h) * 256;
                float* hvb = p->hv + ((((size_t)1 * 2 + b) * 128 + ch) * 4 + h) * 256;
                hvf[d] = __expf(bmidf); hvf[128 + d] = __expf(blastf - bmidf);
                hvb[d] = __expf(bmidb); hvb[128 + d] = __expf(totb - bmidb);
            }
            __syncthreads();
        }
    }
}
__device__ __forceinline__ bf16x8 tr8(const LAS unsigned char* a0, const LAS unsigned char* a1) {
    const s16x4 lo = __builtin_amdgcn_ds_read_tr16_b64_v4i16((LAS s16x4*)a0);
    const s16x4 hi = __builtin_amdgcn_ds_read_tr16_b64_v4i16((LAS s16x4*)a1);
    bf16x8 r; r[0] = lo[0]; r[1] = lo[1]; r[2] = lo[2]; r[3] = lo[3]; r[4] = hi[0]; r[5] = hi[1]; r[6] = hi[2]; r[7] = hi[3]; return r;
}
__device__ __forceinline__ int t5_bucket(int rel) {
    const int n = rel < 0 ? -rel : rel;
    int v;
    if (n < 8) v = n;
    else { const float nf = (float)n; int lg = 8 + (int)(logf(nf / 8.0f) / 2.772588722239781f * 8.0f); v = lg < 15 ? lg : 15; }
    return (rel > 0 ? 16 : 0) + v;
}

__device__ __forceinline__ void attn_item(PC p, int wv, int L, int item, LAS unsigned char* lds) {
    const int tid = otid(), wave = tid >> 6, lane = tid & 63, g = lane >> 5, j = lane & 31;
    const int m = wv >> 2, qs = wv & 3;
    const int b = item >> 8, h = (item >> 6) & 3, qb = item & 63;
    const size_t tok0 = (size_t)b * SEQ;
    const int q0 = qb * 128 + qs * 32;
    const u16* z = p->R0;
    LAS float* lut = (LAS float*)(lds + 116736);
    float lam, M2; const float lam_init = 0.8f - 0.6f * __expf(-0.3f * (float)L);
    {
        const float* lp = p->a_lambda + L * 256;
        const float s1 = wave_sum(lp[lane] * lp[64 + lane]), s2 = wave_sum(lp[128 + lane] * lp[192 + lane]);
        lam = __expf(s1) - __expf(s2) + lam_init;
        const float gq = wave_max(fabsf(p->a_qnorm[L * 64 + lane])), gk = wave_max(fabsf(p->a_knorm[L * 64 + lane]));
        const float tb = wave_max(fabsf(p->rel_bias[(lane & 31) * 4 + h]));
        M2 = 8.0f * LOG2E * gq * gk + LOG2E * tb;
    }
    if (tid < 257) lut[tid] = p->rel_bias[t5_bucket(tid - 128) * 4 + h] * LOG2E - M2;
    bf16x8 Qf[4];
    {
        const u16* qp = z + (tok0 + q0 + j) * NIN + ZA + h * 128 + m * 64 + 8 * g;
#pragma unroll
        for (int ks = 0; ks < 4; ++ks) Qf[ks] = *(const bf16x8*)(qp + 16 * ks);
    }
    const u16* zb = z + tok0 * NIN + h * 128;
    unsigned ksrc[2], vsrc[2]; int kdst[2]; int vdst[2];
#pragma unroll
    for (int i = 0; i < 2; ++i) {
        const int c = tid + 512 * i;
        { const int mm = c >> 9, key = (c >> 3) & 63, ch = c & 7; ksrc[i] = (unsigned)(key * NIN + 512 + mm * 64 + ch * 8); kdst[i] = mm * 9216 + key * 144 + ch * 16; }
        { const int key = c >> 4, ch = c & 15; vsrc[i] = (unsigned)(key * NIN + 1024 + ch * 8); vdst[i] = 18432 + key * 320 + ch * 16; }
    }
    u32x4 sk[2], sv[2];
#pragma unroll
    for (int i = 0; i < 2; ++i) { sk[i] = *(const u32x4*)(zb + ksrc[i]); sv[i] = *(const u32x4*)(zb + vsrc[i]); }
#pragma unroll
    for (int i = 0; i < 2; ++i) { *(LAS u32x4*)(lds + kdst[i]) = sk[i]; *(LAS u32x4*)(lds + vdst[i]) = sv[i]; }
    __syncthreads();
    const float cpos = lut[256], cneg = lut[0];
    f32x16 O[4];
#pragma unroll
    for (int i = 0; i < 4; ++i)
#pragma unroll
        for (int r = 0; r < 16; ++r) O[i][r] = 0.f;
    float lsum = 0.f;
    const int trq = (lane & 15) >> 2, trp = lane & 3, trh = (lane >> 4) & 1;
    const int troff = trq * 320 + (16 * trh + 4 * trp) * 2;
    bf16x8 p0a, p0b, p1a, p1b;
    auto H1 = [&](int t) {
        const int k0 = t * 64;
        const LAS unsigned char* Kb = lds + (t % 3) * 38912 + m * 9216;
        const int relmin = k0 - (q0 + 31), relmax = k0 + 63 - q0;
        const int mode = relmin >= 128 ? 1 : (relmax <= -128 ? 2 : 0);
        const float c0 = mode == 1 ? cpos : (mode == 2 ? cneg : 0.f);
        f32x16 st0;
        bf16x8 kfa[4];
#pragma unroll
        for (int ks = 0; ks < 4; ++ks) kfa[ks] = *(const LAS bf16x8*)(Kb + j * 144 + ks * 32 + g * 16);
#pragma unroll
        for (int r = 0; r < 16; ++r) st0[r] = c0;
#pragma unroll
        for (int ks = 0; ks < 4; ++ks) st0 = mfma32(kfa[ks], Qf[ks], st0);
#define AT_SOFT(ST, KT, PA, PB) { float pv[16]; \
            if (mode != 0) { _Pragma("unroll") for (int r = 0; r < 16; ++r) pv[r] = __builtin_amdgcn_exp2f(ST[r]); } \
            else { _Pragma("unroll") for (int r = 0; r < 16; ++r) { const int key = k0 + 32 * (KT) + (r >> 2) * 8 + 4 * g + (r & 3); \
                    int rel = key - (q0 + j); rel = rel < -128 ? -128 : (rel > 128 ? 128 : rel); pv[r] = __builtin_amdgcn_exp2f(ST[r] + lut[rel + 128]); } } \
            float ls = 0.f; _Pragma("unroll") for (int r = 0; r < 16; ++r) ls += pv[r]; lsum += ls; \
            u32x4 qa, qb; qa.x = pack2(pv[0], pv[1]); qa.y = pack2(pv[2], pv[3]); qa.z = pack2(pv[4], pv[5]); qa.w = pack2(pv[6], pv[7]); \
            qb.x = pack2(pv[8], pv[9]); qb.y = pack2(pv[10], pv[11]); qb.z = pack2(pv[12], pv[13]); qb.w = pack2(pv[14], pv[15]); \
            PA = __builtin_bit_cast(bf16x8, qa); PB = __builtin_bit_cast(bf16x8, qb); }
#pragma unroll
        for (int ks = 0; ks < 4; ++ks) kfa[ks] = *(const LAS bf16x8*)(Kb + (32 + j) * 144 + ks * 32 + g * 16);
        AT_SOFT(st0, 0, p0a, p0b)
#pragma unroll
        for (int r = 0; r < 16; ++r) st0[r] = c0;
#pragma unroll
        for (int ks = 0; ks < 4; ++ks) st0 = mfma32(kfa[ks], Qf[ks], st0);
        AT_SOFT(st0, 1, p1a, p1b)
#undef AT_SOFT
    };
    auto H2 = [&](int t) {
        const LAS unsigned char* vr0 = lds + (t % 3) * 38912 + 18432 + (4 * g) * 320 + troff;
        bf16x8 va[4], vb[4];
#define AT_TRV(dst, KS) { _Pragma("unroll") for (int dvt = 0; dvt < 4; ++dvt) dst[dvt] = tr8(vr0 + (KS) * 16 * 320 + dvt * 64, vr0 + (KS) * 16 * 320 + 8 * 320 + dvt * 64); }
#define AT_PV(FR, PB_) { _Pragma("unroll") for (int dvt = 0; dvt < 4; ++dvt) O[dvt] = mfma32(FR[dvt], PB_, O[dvt]); }
        AT_TRV(va, 0)
        AT_PV(va, p0a)
        AT_TRV(vb, 1)
        AT_PV(vb, p0b)
        AT_TRV(va, 2)
        AT_PV(va, p1a)
        AT_TRV(vb, 3)
        AT_PV(vb, p1b)
#undef AT_TRV
#undef AT_PV
    };
    for (int t = 0; t <= 128; ++t) {
        const bool more = t + 1 < 128;
        const int nb = ((t + 1) % 3) * 38912;
        const u16* zt = zb + (size_t)(t + 1) * 64 * NIN;
        u32x4 s0, s1;
        if (more) { s0 = *(const u32x4*)(zt + ksrc[0]); s1 = *(const u32x4*)(zt + ksrc[1]); }
        if (m == 1 && t >= 1) H2(t - 1);
        if (m == 0 && t < 128) H1(t);
        if (more) {
            *(LAS u32x4*)(lds + nb + kdst[0]) = s0; *(LAS u32x4*)(lds + nb + kdst[1]) = s1;
            s0 = *(const u32x4*)(zt + vsrc[0]); s1 = *(const u32x4*)(zt + vsrc[1]);
        }
        if (m == 1 && t < 128) H1(t);
        if (m == 0 && t < 128) H2(t);
        if (more) { *(LAS u32x4*)(lds + nb + vdst[0]) = s0; *(LAS u32x4*)(lds + nb + vdst[1]) = s1; }
        __syncthreads();
    }
    lsum = sum32(lsum);
    const float inv = 1.0f / lsum;
    LAS float* Oex = (LAS float*)lds;
    if (m == 1) {
#pragma unroll
        for (int dvt = 0; dvt < 4; ++dvt)
#pragma unroll
            for (int r = 0; r < 16; ++r) { const int dv = 32 * dvt + (r >> 2) * 8 + 4 * g + (r & 3); Oex[(qs * 128 + dv) * 32 + j] = O[dvt][r] * inv; }
    }
    __syncthreads();
    if (m == 0) {
        float ssq = 0.f;
#pragma unroll
        for (int dvt = 0; dvt < 4; ++dvt)
#pragma unroll
            for (int r = 0; r < 16; ++r) { const int dv = 32 * dvt + (r >> 2) * 8 + 4 * g + (r & 3); const float o = O[dvt][r] * inv - lam * Oex[(qs * 128 + dv) * 32 + j]; O[dvt][r] = o; ssq += o * o; }
        ssq = sum32(ssq);
        const float sc = rsqrtf(ssq * (1.0f / 128.0f) + 1e-6f) * (1.0f - lam_init);
        const float* sg = p->a_subln + L * 128;
        u16* dst = p->mix + (tok0 + q0 + j) * DM + h * 128;
#pragma unroll
        for (int dvt = 0; dvt < 4; ++dvt)
#pragma unroll
            for (int r4 = 0; r4 < 4; ++r4) {
                const int dv = 32 * dvt + r4 * 8 + 4 * g;
                u32x2 o; o.x = pack2(O[dvt][4 * r4 + 0] * sc * sg[dv + 0], O[dvt][4 * r4 + 1] * sc * sg[dv + 1]);
                o.y = pack2(O[dvt][4 * r4 + 2] * sc * sg[dv + 2], O[dvt][4 * r4 + 3] * sc * sg[dv + 3]);
                *(u32x2*)(dst + dv) = o;
            }
    }
    __syncthreads();
}
__device__ __forceinline__ void hgrn_item(PC p, int wv, int L, int item, LAS unsigned char* lds) {
    const int tid = otid(), wave = tid >> 6, lane = tid & 63, g = lane >> 5, j = lane & 31;
    const int dir = item >> 3, b = (item >> 2) & 1, h = item & 3;
    const u16* z = p->R0;
    LAS unsigned char* Qt = lds;
    LAS unsigned char* Kt = lds + 17408;
    LAS unsigned char* Vt = lds + 37888;
    LAS unsigned char* Sb = lds + 58368;
    LAS unsigned char* Ab = lds + 99328;
    LAS float* vec = (LAS float*)(lds + 108544);
    const int tt = wave & 1, dvt = wave >> 1;
    const int trq = (lane & 15) >> 2, trp = lane & 3, trh = (lane >> 4) & 1;
    const int troff = (8 * g + trq) * 320 + (16 * trh + 4 * trp) * 2;
    const u16* qsrc; const u16* ksrc; const u16* vsrc; size_t qld;
    if (dir == 0) { qsrc = z + ZH + h * 128; qld = NIN; ksrc = z + ZH + 512 + h * 128; }
    else { qsrc = p->qmb + h * 128; qld = 512; ksrc = z + ZH + 1024 + h * 128; }
    vsrc = z + ZH + 1536 + h * 128;
    u32x4 rq[2], rk[2], rv[2]; float rvec = 0.f;
    auto gload = [&](int c) {
        const size_t tokb = (size_t)b * SEQ + (size_t)c * 64;
#pragma unroll
        for (int i = 0; i < 2; ++i) {
            const int cc = tid + 512 * i, row = cc >> 4, ch = cc & 15;
            rq[i] = *(const u32x4*)(qsrc + (tokb + row) * qld + ch * 8);
            rk[i] = *(const u32x4*)(ksrc + (tokb + row) * NIN + ch * 8);
            rv[i] = *(const u32x4*)(vsrc + (tokb + row) * NIN + ch * 8);
        }
        if (tid < 256) rvec = p->hv[((((size_t)dir * 2 + b) * 128 + c) * 4 + h) * 256 + tid];
    };
    auto lstore = [&]() {
#pragma unroll
        for (int i = 0; i < 2; ++i) {
            const int cc = tid + 512 * i, row = cc >> 4, ch = cc & 15;
            *(LAS u32x4*)(Qt + row * 272 + ch * 16) = rq[i];
            *(LAS u32x4*)(Kt + row * 320 + ch * 16) = rk[i];
            *(LAS u32x4*)(Vt + row * 320 + ch * 16) = rv[i];
        }
        if (tid < 256) vec[tid] = rvec;
    };
    f32x16 S[2];
#pragma unroll
    for (int i = 0; i < 2; ++i)
#pragma unroll
        for (int r = 0; r < 16; ++r) S[i][r] = 0.f;
    gload(dir == 0 ? 0 : 127);
    lstore();
    __syncthreads();
    for (int ci = 0; ci < 128; ++ci) {
        const int c = dir == 0 ? ci : 127 - ci;
        if (ci + 1 < 128) gload(dir == 0 ? ci + 1 : 126 - ci);
#pragma unroll
        for (int i = 0; i < 2; ++i) {
            const int dkb = (2 * tt + i) * 32;
#pragma unroll
            for (int r = 0; r < 16; ++r) {
                const int dk = dkb + (r >> 2) * 8 + 4 * g + (r & 3);
                S[i][r] *= vec[dk];
                *(LAS u16*)(Sb + dk * 320 + (32 * dvt + j) * 2) = f2bf(S[i][r]);
            }
        }
        if (wave < 4) {
            const int at = wave & 1, as = wave >> 1;
            f32x16 acc;
#pragma unroll
            for (int r = 0; r < 16; ++r) acc[r] = 0.f;
#pragma unroll
            for (int ks = 0; ks < 8; ++ks) {
                const bf16x8 a = *(const LAS bf16x8*)(Qt + (32 * at + j) * 272 + ks * 32 + g * 16);
                const bf16x8 bb = *(const LAS bf16x8*)(Kt + (32 * as + j) * 320 + ks * 32 + g * 16);
                acc = mfma32(a, bb, acc);
            }
            const int s = 32 * as + j;
#pragma unroll
            for (int r = 0; r < 16; ++r) {
                const int t = 32 * at + (r >> 2) * 8 + 4 * g + (r & 3);
                const bool keep = dir == 0 ? (s <= t) : (s >= t);
                *(LAS u16*)(Ab + t * 144 + s * 2) = f2bf(keep ? acc[r] : 0.f);
            }
        }
        __syncthreads();
        {
            bf16x8 Vf[4];
#pragma unroll
            for (int ks = 0; ks < 4; ++ks) { const LAS unsigned char* a0 = Vt + ks * 16 * 320 + troff + dvt * 64; Vf[ks] = tr8(a0, a0 + 4 * 320); }
            f32x16 acc;
#pragma unroll
            for (int r = 0; r < 16; ++r) acc[r] = 0.f;
#pragma unroll
            for (int ks = 0; ks < 8; ++ks) {
                const bf16x8 a = *(const LAS bf16x8*)(Qt + (32 * tt + j) * 272 + ks * 32 + g * 16);
                const LAS unsigned char* a0 = Sb + ks * 16 * 320 + troff + dvt * 64;
                acc = mfma32(a, tr8(a0, a0 + 4 * 320), acc);
            }
#pragma unroll
            for (int ks = 0; ks < 4; ++ks) {
                const bf16x8 a = *(const LAS bf16x8*)(Ab + (32 * tt + j) * 144 + ks * 32 + g * 16);
                acc = mfma32(a, Vf[ks], acc);
            }
            {
                const size_t tokb = (size_t)b * SEQ + (size_t)c * 64;
                u16* dst = dir == 0 ? p->mix + tokb * DM + 512 + h * 128 + 32 * dvt + j : p->ob + tokb * 512 + h * 128 + 32 * dvt + j;
                const size_t ld = dir == 0 ? DM : 512;
#pragma unroll
                for (int r = 0; r < 16; ++r) { const int t = 32 * tt + (r >> 2) * 8 + 4 * g + (r & 3); dst[(size_t)t * ld] = f2bf(acc[r]); }
            }
#pragma unroll
            for (int i = 0; i < 2; ++i) {
                const int dkb = (2 * tt + i) * 32;
#pragma unroll
                for (int ks = 0; ks < 4; ++ks) {
                    const LAS unsigned char* a0 = Kt + ks * 16 * 320 + troff + dkb * 2;
                    S[i] = mfma32(tr8(a0, a0 + 4 * 320), Vf[ks], S[i]);
                }
#pragma unroll
                for (int r = 0; r < 16; ++r) { const int dk = dkb + (r >> 2) * 8 + 4 * g + (r & 3); S[i][r] *= vec[128 + dk]; }
            }
        }
        __syncthreads();
        if (ci + 1 < 128) lstore();
        __syncthreads();
    }
}
__device__ __forceinline__ void rwkv_item(PC p, int wv, int L, int item, LAS unsigned char* lds) {
    const int tid = otid(), wave = tid >> 6, lane = tid & 63;
    const int dir = item >> 6, b = (item >> 5) & 1, head = (item >> 2) & 7, quarter = item & 3;
    const int rl = lane >> 4, kq = lane & 15, rowl = wave * 4 + rl;
    float __attribute__((ext_vector_type(2))) SA = {0.f, 0.f}, SB = {0.f, 0.f};
    const _Float16* src[3]; int dsto[3]; int rowi[3];
#pragma unroll
    for (int i = 0; i < 3; ++i) {
        const int hi = wv >> 2;
        const int q = tid + 512 * i, arr = 2 * i + hi, row = (q >> 3) & 31, ch8 = q & 7;
        const _Float16* sh = i == 0 ? p->ra[0] : i == 1 ? p->ra[1] : p->ra[2];
        const _Float16* sf = i == 0 ? p->ra[3] : i == 1 ? p->ra[4] : p->ra[5];
        const _Float16* sb = i == 0 ? p->ra[6] : i == 1 ? p->ra[7] : p->ra[8];
        const _Float16* base = hi ? (dir ? sb : sf) : sh;
        src[i] = base + (size_t)b * SEQ * 512 + head * 64 + ch8 * 8;
        dsto[i] = arr * 8192 + row * 256 + ch8 * 32; rowi[i] = row;
    }
    u32x4 st[3];
    auto gload = [&](int c) {
#pragma unroll
        for (int i = 0; i < 3; ++i) { const int step = c * 32 + rowi[i], t = dir == 0 ? step : SEQ - 1 - step; st[i] = *(const u32x4*)(src[i] + (size_t)t * 512); }
    };
    auto lstore = [&](int buf) {
#pragma unroll
        for (int i = 0; i < 3; ++i) {
            typedef _Float16 h2 __attribute__((ext_vector_type(2)));
            f32x4 lo, hi;
            const h2 a0 = __builtin_bit_cast(h2, (unsigned)st[i].x), a1 = __builtin_bit_cast(h2, (unsigned)st[i].y), a2 = __builtin_bit_cast(h2, (unsigned)st[i].z), a3 = __builtin_bit_cast(h2, (unsigned)st[i].w);
            lo[0] = (float)a0[0]; lo[1] = (float)a0[1]; lo[2] = (float)a1[0]; lo[3] = (float)a1[1];
            hi[0] = (float)a2[0]; hi[1] = (float)a2[1]; hi[2] = (float)a3[0]; hi[3] = (float)a3[1];
            LAS unsigned char* d = lds + buf * 49152 + dsto[i];
            *(LAS f32x4*)d = lo; *(LAS f32x4*)(d + 16) = hi;
        }
    };
    gload(0); lstore(0);
    __syncthreads();
    for (int c = 0; c < 256; ++c) {
        const int buf = c & 1;
        if (c + 1 < 256) gload(c + 1);
        const LAS float* B = (const LAS float*)(lds + buf * 49152);
        LAS float* Yb = (LAS float*)(lds + 98304 + buf * 8192);
        typedef float f32x2 __attribute__((ext_vector_type(2)));
#define RW_LD(S_) { const LAS float* q_ = B + (S_) * 64 + 4 * kq; \
            const f32x4 r_ = *(const LAS f32x4*)q_, w_ = *(const LAS f32x4*)(q_ + 2048), k_ = *(const LAS f32x4*)(q_ + 4096), b_ = *(const LAS f32x4*)(q_ + 6144), e_ = *(const LAS f32x4*)(q_ + 10240); \
            rA = r_.xy; rB = r_.zw; wA = w_.xy; wB = w_.zw; kA = k_.xy; kB = k_.zw; bA = b_.xy; bB = b_.zw; eA = e_.xy; eB = e_.zw; vvn = B[8192 + (S_) * 64 + quarter * 16 + rowl]; }
        if (wv < 4) {
        f32x2 rA, rB, wA, wB, kA, kB, bA, bB, eA, eB; float vvn;
        RW_LD(0)
#pragma unroll
        for (int s = 0; s < 32; ++s) {
            const f32x2 r0 = rA, r1 = rB, w0 = wA, w1 = wB, k0 = kA, k1 = kB, b0 = bA, b1 = bB, e0 = eA, e1 = eB; const float vv = vvn;
            if (s + 1 < 32) RW_LD(s + 1)
            const f32x2 sa2 = SA * k0 + SB * k1;
            const float sa = allreduce16(sa2.x + sa2.y);
            const f32x2 sav = {sa, sa}, vvv = {vv, vv};
            SA = SA * w0 + (vvv * e0 - sav * b0);
            SB = SB * w1 + (vvv * e1 - sav * b1);
            const f32x2 y2 = SA * r0 + SB * r1;
            float yq = y2.x + y2.y;
            yq += dppmov<0xB1>(yq); yq += dppmov<0x4E>(yq);
            Yb[(s * 16 + rowl) * 4 + (kq >> 2)] = yq;
        }
        }
#undef RW_LD
        if (c + 1 < 256) lstore(buf ^ 1);
        __syncthreads();
        if (tid >= 256 && tid < 384) {
            const int u = tid - 256, s = u >> 2, r4i = (u & 3) * 4, step = c * 32 + s, t = dir == 0 ? step : SEQ - 1 - step;
            const size_t tok = (size_t)b * SEQ + t;
            f32x4 yv;
#pragma unroll
            for (int i = 0; i < 4; ++i) { const f32x4 q = *(const LAS f32x4*)(Yb + (s * 16 + r4i + i) * 4); yv[i] = (q[0] + q[1]) + (q[2] + q[3]); }
            u32x2 o; o.x = pack2(yv[0], yv[1]); o.y = pack2(yv[2], yv[3]);
            u16* dst = dir == 0 ? p->mix + tok * DM + 1536 + head * 64 + quarter * 16 + r4i : p->yb + tok * 512 + head * 64 + quarter * 16 + r4i;
            *(u32x2*)dst = o;
        }
    }
    __syncthreads();
}

__device__ __forceinline__ void phase_mixer(PC p, int wv, int L, LAS unsigned char* lds) {
    LAS int* slot = (LAS int*)(lds + 131072 - 16);
    for (;;) {
        __syncthreads();
        if (otid() == 0) *slot = (int)atomicAdd(p->ctr + L * 16, 1u);
        __syncthreads();
        const int it = *slot;
        if (it >= 128 + 16 + 512) break;
        if (it < 128) rwkv_item(p, wv, L, it, lds);
        else if (it < 144) hgrn_item(p, wv, L, it - 128, lds);
        else attn_item(p, wv, L, it - 144, lds);
    }
}
__device__ __forceinline__ void phase_post(PC p, int wv, int L, LAS unsigned char* lds) {
    const int tid = otid(), wave = tid >> 6, lane = tid & 63;
    const u16* z = p->R0;
    for (int it = blockIdx.x; it < 512; it += gridDim.x) {
        const int tok0 = it * 32;
        {
            const int t = tid >> 4, sub = tid & 15, hh = sub >> 2, pc = (sub & 3) * 32, tok = tok0 + t;
            u16* mo = p->mix + (size_t)tok * DM + 512 + hh * 128 + pc;
            const u16* ob = p->ob + (size_t)tok * 512 + hh * 128 + pc;
            const u16* gz = z + (size_t)tok * NIN + ZH + 2048 + hh * 128 + pc;
            const float* gn = p->h_onorm + L * 128 + pc;
            float o[32]; float ss = 0.f;
#pragma unroll
            for (int i = 0; i < 4; ++i) {
                const u32x4 a = ((const u32x4*)mo)[i], bq = ((const u32x4*)ob)[i];
                o[8 * i + 0] = bflo(a.x) + bflo(bq.x); o[8 * i + 1] = bfhi(a.x) + bfhi(bq.x); o[8 * i + 2] = bflo(a.y) + bflo(bq.y); o[8 * i + 3] = bfhi(a.y) + bfhi(bq.y);
                o[8 * i + 4] = bflo(a.z) + bflo(bq.z); o[8 * i + 5] = bfhi(a.z) + bfhi(bq.z); o[8 * i + 6] = bflo(a.w) + bflo(bq.w); o[8 * i + 7] = bfhi(a.w) + bfhi(bq.w);
            }
#pragma unroll
            for (int i = 0; i < 32; ++i) ss += o[i] * o[i];
            ss += dppmov<0xB1>(ss); ss += dppmov<0x4E>(ss);
            const float ri = rsqrtf(ss * (1.0f / 128.0f) + 1e-6f);
#pragma unroll
            for (int i = 0; i < 4; ++i) {
                const u32x4 gq = ((const u32x4*)gz)[i];
                const float gv[8] = {bflo(gq.x), bfhi(gq.x), bflo(gq.y), bfhi(gq.y), bflo(gq.z), bfhi(gq.z), bflo(gq.w), bfhi(gq.w)};
                float r[8];
#pragma unroll
                for (int e = 0; e < 8; ++e) r[e] = o[8 * i + e] * ri * gn[8 * i + e] * (gv[e] * sigmoidf_(gv[e]));
                u32x4 w; w.x = pack2(r[0], r[1]); w.y = pack2(r[2], r[3]); w.z = pack2(r[4], r[5]); w.w = pack2(r[6], r[7]);
                ((u32x4*)mo)[i] = w;
            }
        }
        LAS unsigned char* actb = lds;
        LAS float* outL = (LAS float*)(lds + 16384);
        {
            const int t = tid >> 4, c8 = (tid & 15) * 8, tok = tok0 + t, s = tok & (SEQ - 1);
            const u16* zc = z + (size_t)tok * NIN + ZR + 1792 + c8;
            const float* mu0 = p->r_mu + (size_t)L * 3840 + 1792 + c8; const float* mu1 = mu0 + 1920;
#pragma unroll
            for (int e = 0; e < 8; ++e) {
                const float zt = bf2f(zc[e]);
                const float zp = s > 0 ? bf2f(zc[e - NIN]) : 0.f, zn = s < SEQ - 1 ? bf2f(zc[e + NIN]) : 0.f;
                *(LAS u16*)(actb + t * 272 + (c8 + e) * 2) = f2bf(sigmoidf_(zt + mu0[e] * (zp - zt) + mu1[e] * (zn - zt)));
            }
        }
        __syncthreads();
        {
            const int col = tid;
            {
                const int g = lane >> 5, j = lane & 31;
#pragma unroll 1
                for (int i = 0; i < 2; ++i) {
                    const int n0 = (2 * wave + i) * 32;
                    const f32x16 c = mm32<128>(actb, 272, p->r_g2 + (size_t)L * 128 * 512 + n0 + j, 512, j, g);
#pragma unroll
                    for (int r = 0; r < 16; ++r) outL[((r >> 2) * 8 + 4 * g + (r & 3)) * 512 + n0 + j] = c[r];
                }
            }
            __syncthreads();
            float acc[32];
#pragma unroll
            for (int t = 0; t < 32; ++t) acc[t] = outL[t * 512 + col];
            const float rkg = p->r_rk[L * 512 + col], gng = p->r_gn_g[L * 512 + col], gnb = p->r_gn_b[L * 512 + col];
            const size_t base = (size_t)tok0 * 512 + col;
            const _Float16* ar = p->ra[0] + base; const _Float16* av = p->ra[2] + base; const _Float16* aef = p->ra[5] + base; const _Float16* aeb = p->ra[8] + base;
#pragma unroll
            for (int t0 = 0; t0 < 32; t0 += 8) {
                float hr[8], hv[8], hf[8], hb[8], yf[8], yb2[8];
#pragma unroll
                for (int i = 0; i < 8; ++i) {
                    const int t = t0 + i;
                    hr[i] = (float)ar[(size_t)t * 512]; hv[i] = (float)av[(size_t)t * 512]; hf[i] = (float)aef[(size_t)t * 512]; hb[i] = (float)aeb[(size_t)t * 512];
                    yf[i] = bf2f(p->mix[(size_t)(tok0 + t) * DM + 1536 + col]); yb2[i] = bf2f(p->yb[(size_t)(tok0 + t) * 512 + col]);
                }
#pragma unroll
                for (int i = 0; i < 8; ++i) {
                    const int t = t0 + i, tok = tok0 + t;
                    const float r = hr[i], v = hv[i], kef = hf[i], keb = hb[i];
                    const float bonus = wave_sum(r * (0.5f * (kef + keb)) * rkg) * v;
                    const float y = yf[i] + yb2[i];
                    const float mean = wave_sum(y) * (1.0f / 64.0f);
                    const float dy = y - mean;
                    const float var = wave_sum(dy * dy) * (1.0f / 64.0f);
                    const float yn = dy * rsqrtf(var + 64e-5f) * gng + gnb;
                    p->mix[(size_t)tok * DM + 1536 + col] = f2bf((yn + bonus) * acc[t]);
                }
            }
        }
        __syncthreads();
    }
}
constexpr int NPH = 18;
__device__ __forceinline__ void grid_barrier(int wv, unsigned k) {
    PC p = (PC)__builtin_amdgcn_kernarg_segment_ptr();
    asm volatile("" : "+s"(p));
    unsigned* w = p->ctr + 48;
    asm volatile("s_waitcnt vmcnt(0)" ::: "memory");
    __syncthreads();
    if (otid() == 0) {
        __builtin_amdgcn_fence(__ATOMIC_RELEASE, "agent");
        asm volatile("s_waitcnt vmcnt(0)" ::: "memory");
        __hip_atomic_fetch_add(w, 1u, __ATOMIC_RELAXED, __HIP_MEMORY_SCOPE_AGENT);
        const unsigned target = k * gridDim.x;
        while (__hip_atomic_load(w, __ATOMIC_RELAXED, __HIP_MEMORY_SCOPE_AGENT) < target) __builtin_amdgcn_s_sleep(2);
        __builtin_amdgcn_fence(__ATOMIC_ACQUIRE, "agent");
        asm volatile("s_waitcnt vmcnt(0)" ::: "memory");
    }
    __syncthreads();
}
template <int L> __device__ __forceinline__ void run_phase(int wv, int s, LAS unsigned char* lds) {
    PC p = (PC)__builtin_amdgcn_kernarg_segment_ptr();
    asm volatile("" : "+s"(p));
    float* sA = L == 0 ? p->ss0 : p->ss1; float* sB = L == 0 ? p->ss1 : p->ss0;
    __syncthreads();
    if (s == 0) phase_conv(p, wv, L, lds, 0);
    else if (s == 1) { EpiZ e; e.Z = p->R0; e.ss = sA; run_gemm(wv, lds, p->mix, p->Wt_in, T_TOK, NINP, DM, e); }
    else if (s == 2) phase_prep(p, wv, L, lds);
    else if (s == 3) phase_mixer(p, wv, L, lds);
    else if (s == 4) phase_post(p, wv, L, lds);
    else if (s == 5) { phase_conv(p, wv, L, lds, 1); __syncthreads(); EpiRes e; e.res = L == 0 ? p->x : p->out; e.out = p->out; e.hb = p->hb0; e.ss_out = sB; run_gemm(wv, lds, p->mix, p->Wt_out, T_TOK, DM, DM, e); }
    else if (s == 6) { EpiUp e; e.H = p->R0; e.ss = sB; run_gemm(wv, lds, p->hb0, p->Wt_up, T_TOK, DFF, DM, e); }
    else if (s == 7) { EpiRes e; e.res = p->out; e.out = p->out; e.hb = p->hb0; e.ss_out = sA; run_gemm(wv, lds, p->R0, p->Wt_down, T_TOK, DM, DFF, e); }
    else {
        { EpiPl e; e.PL = p->R0; run_gemm(wv, lds, p->pb, p->Wt_ple, T_TOK, DM, 256, e); }
        __syncthreads();
        { EpiGate<(L == 1)> e; e.PL = p->R0; e.out = p->out; e.hb = p->mix; e.ss = sA; e.ss_out = sB; run_gemm(wv, lds, p->hb0, p->Wt_gate, T_TOK, DM, DM, e); }
    }
}
#ifndef FUSED_LAUNCH
#define FUSED_LAUNCH 1
#endif
#if !FUSED_LAUNCH
__global__ __launch_bounds__(512, 2) void mk_phase(Params p_, int ph) {
    extern __shared__ __attribute__((aligned(16))) unsigned char shm[];
    LAS unsigned char* lds = (LAS unsigned char*)shm;
    const int wv = __builtin_amdgcn_readfirstlane((int)(threadIdx.x >> 6));
    if (ph < 9) run_phase<0>(wv, ph, lds); else run_phase<1>(wv, ph - 9, lds);
}
#else
#define MK_PH(L, S, K) run_phase<L>(wv, S, lds); grid_barrier(wv, K);
__global__ __launch_bounds__(512, 2) void mk_forward(Params p_) {
    extern __shared__ __attribute__((aligned(16))) unsigned char shm[];
    LAS unsigned char* lds = (LAS unsigned char*)shm;
    const int wv = __builtin_amdgcn_readfirstlane((int)(threadIdx.x >> 6));
    run_phase<0>(wv, 0, lds); cg::this_grid().sync();
    MK_PH(0, 1, 1) MK_PH(0, 2, 2) MK_PH(0, 3, 3) MK_PH(0, 4, 4) MK_PH(0, 5, 5) MK_PH(0, 6, 6) MK_PH(0, 7, 7) MK_PH(0, 8, 8)
    MK_PH(1, 0, 9) MK_PH(1, 1, 10) MK_PH(1, 2, 11) MK_PH(1, 3, 12) MK_PH(1, 4, 13) MK_PH(1, 5, 14) MK_PH(1, 6, 15) MK_PH(1, 7, 16)
    run_phase<1>(wv, 8, lds);
}
#endif

extern "C" void kernel_launch(void* const* d_in, const int* in_sizes, int n_in, void* d_out, int out_size, void* d_ws, size_t ws_size, hipStream_t stream) {
    (void)in_sizes; (void)n_in; (void)out_size;
    Params p{};
    const float* const* in = (const float* const*)d_in;
    p.x = in[0]; p.p = in[1]; p.mix_norm_g = in[2]; p.w_in = in[3]; p.w_out = in[4]; p.rel_bias = in[5]; p.a_qnorm = in[6]; p.a_knorm = in[7]; p.a_lambda = in[8]; p.a_subln = in[9];
    p.h_lb = in[10]; p.h_onorm = in[11]; p.c_w = in[12]; p.c_b = in[13]; p.c_scale = in[14]; p.r_mu = in[15]; p.r_w0 = in[16]; p.r_w2 = in[17]; p.r_a0 = in[18]; p.r_a2 = in[19];
    p.r_g2 = in[20]; p.r_kk = in[21]; p.r_ka = in[22]; p.r_rk = in[23]; p.r_gn_g = in[24]; p.r_gn_b = in[25]; p.mlp_norm_g = in[26]; p.w_up = in[27]; p.w_down = in[28];
    p.ple_norm_g = in[29]; p.w_ple = in[30]; p.w_gate = in[31];
    p.out = (float*)d_out;
    unsigned char* w = (unsigned char*)d_ws; size_t off = 0;
    auto take = [&](size_t bytes) { unsigned char* r = w + off; off += (bytes + 255) & ~(size_t)255; return r; };
    p.R0 = (u16*)take((size_t)T_TOK * DFF * 2);
    const size_t zbytes = (size_t)T_TOK * NIN * 2;
    p.ob = (u16*)((unsigned char*)p.R0 + zbytes);
    p.yb = p.ob + (size_t)T_TOK * 512;
    p.qmb = p.yb + (size_t)T_TOK * 512;
    p.mix = (u16*)take((size_t)T_TOK * DM * 2);
    p.hb0 = (u16*)take((size_t)T_TOK * DM * 2);
    p.Wt_in = (u16*)take((size_t)NINP * DM * 2);
    p.Wt_out = (u16*)take((size_t)DM * DM * 2);
    p.Wt_up = (u16*)take((size_t)DFF * DM * 2);
    p.Wt_down = (u16*)take((size_t)DM * DFF * 2);
    p.Wt_gate = (u16*)take((size_t)DM * DM * 2);
    p.Wt_ple = (u16*)take((size_t)DM * 256 * 2);
    p.pb = (u16*)take((size_t)T_TOK * 256 * 2);
    { unsigned char* r4 = (unsigned char*)p.Wt_up; for (int i = 0; i < 4; ++i) p.ra[i] = (_Float16*)(r4 + (size_t)i * T_TOK * 512 * 2);
      for (int i = 0; i < 4; ++i) p.ra[4 + i] = (_Float16*)((unsigned char*)p.hb0 + (size_t)i * T_TOK * 512 * 2);
      p.ra[8] = (_Float16*)take((size_t)T_TOK * 512 * 2); }
    p.hv = (float*)take((size_t)2 * 2 * 128 * 4 * 256 * 4);
    p.ss0 = (float*)take((size_t)T_TOK * 32 * 4);
    p.ss1 = (float*)take((size_t)T_TOK * 32 * 4);
    p.ctr = (unsigned*)take(256);
    if (off > ws_size) fprintf(stderr, "workspace too small: need %zu have %zu\n", off, ws_size);
    constexpr size_t kLds = 131072;
    hipMemsetAsync(p.ctr, 0, 256, stream);
#if FUSED_LAUNCH
    static int grid_blocks = 0;
    if (!grid_blocks) {
        hipFuncSetAttribute((const void*)mk_forward, hipFuncAttributeMaxDynamicSharedMemorySize, (int)kLds);
        int dev = 0, cus = 0, per_cu = 0;
        hipGetDevice(&dev);
        hipDeviceGetAttribute(&cus, hipDeviceAttributeMultiprocessorCount, dev);
        hipOccupancyMaxActiveBlocksPerMultiprocessor(&per_cu, mk_forward, 512, kLds);
        if (per_cu < 1) per_cu = 1;
        grid_blocks = cus;
    }
    void* args[] = {&p};
    hipError_t e = hipLaunchCooperativeKernel((const void*)mk_forward, dim3(grid_blocks), dim3(512), args, kLds, stream);
    if (e != hipSuccess) fprintf(stderr, "cooperative launch failed: %s (grid %d)\n", hipGetErrorString(e), grid_blocks);
#else
    static int inited = 0;
    if (!inited) { hipFuncSetAttribute((const void*)mk_phase, hipFuncAttributeMaxDynamicSharedMemorySize, (int)kLds); inited = 1; }
    for (int ph = 0; ph < NPH; ++ph) mk_phase<<<256, 512, kLds, stream>>>(p, ph);
#endif
}
```

```cpp
#include <hip/hip_runtime.h>
#include <hip/hip_cooperative_groups.h>
#include <cstdio>
namespace cg = cooperative_groups;
typedef unsigned short u16;
typedef short s16x4 __attribute__((ext_vector_type(4)));
typedef float f32x16 __attribute__((ext_vector_type(16)));
typedef unsigned u32x4 __attribute__((ext_vector_type(4)));
typedef unsigned u32x2 __attribute__((ext_vector_type(2)));
#define LAS __attribute__((address_space(3)))

constexpr int T_TOK = 16384, SEQ = 8192, DM = 2048, NIN = 6528, NINP = 6656, DFF = 8192;
constexpr float LOG2E = 1.4426950408889634f;

__device__ __forceinline__ u16 f2bf(float f) { unsigned u = __float_as_uint(f); u += 0x7FFFu + ((u >> 16) & 1u); return (u16)(u >> 16); }
__device__ __forceinline__ float bf2f(u16 b) { return __uint_as_float(((unsigned)b) << 16); }
typedef __bf16 bf2_t __attribute__((ext_vector_type(2)));
__device__ __forceinline__ unsigned pack2(float lo, float hi) { bf2_t v; v[0] = (__bf16)lo; v[1] = (__bf16)hi; return __builtin_bit_cast(unsigned, v); }
__device__ __forceinline__ float bflo(unsigned v) { return __uint_as_float(v << 16); }
__device__ __forceinline__ float bfhi(unsigned v) { return __uint_as_float(v & 0xffff0000u); }
__device__ __forceinline__ float sigmoidf_(float x) { return 1.0f / (1.0f + __expf(-x)); }
template <int CTRL> __device__ __forceinline__ float dppmov(float v) {
    return __builtin_bit_cast(float, __builtin_amdgcn_update_dpp(0, __builtin_bit_cast(int, v), CTRL, 0xF, 0xF, true));
}
__device__ __forceinline__ float swz16(float v) { return __builtin_bit_cast(float, __builtin_amdgcn_ds_swizzle(__builtin_bit_cast(int, v), 0x401F)); }
__device__ __forceinline__ float sum32(float v) {
    const unsigned u = __builtin_bit_cast(unsigned, v);
    auto r = __builtin_amdgcn_permlane32_swap(u, u, false, false);
    return __builtin_bit_cast(float, (unsigned)r[0]) + __builtin_bit_cast(float, (unsigned)r[1]);
}
__device__ __forceinline__ float max32(float v) {
    const unsigned u = __builtin_bit_cast(unsigned, v);
    auto r = __builtin_amdgcn_permlane32_swap(u, u, false, false);
    return fmaxf(__builtin_bit_cast(float, (unsigned)r[0]), __builtin_bit_cast(float, (unsigned)r[1]));
}
__device__ __forceinline__ float allreduce16(float v) {
    v += dppmov<0xB1>(v); v += dppmov<0x4E>(v); v += dppmov<0x141>(v); v += dppmov<0x140>(v); return v;
}
__device__ __forceinline__ float wave_sum(float v) { v = allreduce16(v); v += swz16(v); return sum32(v); }
__device__ __forceinline__ float wave_max(float v) {
    v = fmaxf(v, dppmov<0xB1>(v)); v = fmaxf(v, dppmov<0x4E>(v)); v = fmaxf(v, dppmov<0x141>(v)); v = fmaxf(v, dppmov<0x140>(v));
    v = fmaxf(v, swz16(v)); return max32(v);
}

__device__ __forceinline__ int otid_(int wv) { unsigned zz = 0u; asm volatile("" : "+v"(zz)); int t = wv * 64 + (int)__builtin_amdgcn_mbcnt_hi(~0u, __builtin_amdgcn_mbcnt_lo(~0u, zz)); return t; }
#define otid() otid_(wv)

struct Params {
    const float *x, *p, *mix_norm_g, *w_in, *w_out, *rel_bias, *a_qnorm, *a_knorm, *a_lambda, *a_subln, *h_lb, *h_onorm, *c_w, *c_b, *c_scale,
        *r_mu, *r_w0, *r_w2, *r_a0, *r_a2, *r_g2, *r_kk, *r_ka, *r_rk, *r_gn_g, *r_gn_b, *mlp_norm_g, *w_up, *w_down, *ple_norm_g, *w_ple, *w_gate;
    float* out;
    u16 *R0, *mix, *hb0, *Wt_in, *Wt_out, *Wt_up, *Wt_down, *Wt_gate, *Wt_ple, *pb, *ob, *yb, *qmb;
    _Float16* ra[9];
    float *hv;
    float *ss0, *ss1;
    unsigned* ctr;
};
typedef const __attribute__((address_space(4))) Params* PC;

namespace pg8 {
#define PG8_LAS __attribute__((address_space(3)))
typedef unsigned short bf16_t;
typedef short bf16x8 __attribute__((ext_vector_type(8)));
typedef float f32x4 __attribute__((ext_vector_type(4)));
constexpr int BM = 256, BK = 64, HALF = 128, HTB = HALF * BK * 2  , STAGE_BYTES = 8 * HTB, NXCD = 8, WGM = 8;

__host__ __device__ __forceinline__ int lds_byte(int r, int c) { const int st = (r >> 4) * 2 + (c >> 5), rr = r & 15, cc = c & 31, ob = rr * 64 + cc * 2; return st * 1024 + (ob ^ (((ob >> 9) & 1) << 5)); }
__host__ __device__ __forceinline__ void stage_rc(int b, int& R, int& C) { const int st = b / 1024, sb = b % 1024, swz = sb ^ (((sb >> 9) & 1) << 5); R = (st >> 1) * 16 + swz / 64; C = (st & 1) * 32 + (swz % 64) / 2; }
__host__ __device__ __forceinline__ int perm32(int rho) { const int n = rho >> 4, i = rho & 15; return 8 * (i >> 2) + 4 * n + (i & 3); }

struct Unit { int pm, pn; };
struct Gemm { const bf16_t* A; const bf16_t* Bt; int M, N, K; };

struct StaticOrder {
    int nM, nN, nwg, G, c;
    __host__ __device__ void init(int M, int N, int G_, int c_) { nM = M / BM; nN = N / BM; nwg = nM * nN; G = G_; c = c_; }
    __host__ __device__ bool next(int i, Unit& u) const {
        const long L = (long)i * G + c; if (L >= nwg) return false;
        int wgid = (int)L; { const int q = nwg / NXCD, r = nwg % NXCD, xcd = wgid % NXCD, off = wgid / NXCD; wgid = (xcd < r ? xcd * (q + 1) : r * (q + 1) + (xcd - r) * q) + off; }
        const int nig = WGM * nN, gid = wgid / nig, fm = gid * WGM, gsz = (nM - fm) < WGM ? (nM - fm) : WGM;
        u.pm = fm + ((wgid % nig) % gsz); u.pn = (wgid % nig) / gsz; return true;
    }
    __device__ __forceinline__ void a_ready(const Unit&) const {}
    __device__ __forceinline__ void done(const Unit&) const {}
};
template <class Epi, class Sched>
__device__ __forceinline__ void gemm_phase(int wv, PG8_LAS unsigned char* lds, const Gemm g, const Sched& S, const Epi& E) {
    const int tid = otid(), wid = __builtin_amdgcn_readfirstlane(tid >> 6), lane = tid & 63, wr = wid >> 2, wc = wid & 3, fr = lane & 15, fq = lane >> 4;
    const int K = g.K, nt = K / BK;
    unsigned voffA[2], voffB[2];
#pragma unroll
    for (int i = 0; i < 2; ++i) { int R, C; stage_rc(tid * 16 + i * 8192, R, C); const int Rb = Epi::PERM ? ((R & ~31) + perm32(R & 31)) : R;
        voffA[i] = (unsigned)(R * K + C) * 2u; voffB[i] = (unsigned)(Rb * K + C) * 2u; }
    const size_t kstep = (size_t)(BK * 2);
    const size_t hstep = (size_t)HALF * K * 2;
    const size_t tstep = 2 * hstep;
    const unsigned ldsw = (unsigned)wid * 1024u;
    const int aoff = lds_byte(wr * 64 + fr, fq * 8), boff = lds_byte(wc * 32 + fr, fq * 8);
#define PG8_SA(b, h) (((b) * 2 + (h)) * HTB)
#define PG8_SB(b, h) ((4 + (b) * 2 + (h)) * HTB)
#define PG8_STAGE(bufoff, gbase, voff) do { _Pragma("unroll") for (int _i = 0; _i < 2; ++_i) \
        __builtin_amdgcn_global_load_lds((const unsigned*)((const char*)(gbase) + (voff)[_i]), (PG8_LAS unsigned*)(lds + (bufoff) + ldsw + _i * 8192), 16, 0, 0); } while (0)
#define PG8_LDA(dst, b, h) do { _Pragma("unroll") for (int m = 0; m < 4; ++m) _Pragma("unroll") for (int k = 0; k < 2; ++k) dst[m][k] = *(const PG8_LAS bf16x8*)(lds + PG8_SA(b, h) + aoff + m * 2048 + k * 1024); } while (0)
#define PG8_LDB(dst, b, h) do { _Pragma("unroll") for (int n = 0; n < 2; ++n) _Pragma("unroll") for (int k = 0; k < 2; ++k) dst[n][k] = *(const PG8_LAS bf16x8*)(lds + PG8_SB(b, h) + boff + n * 2048 + k * 1024); } while (0)
#define PG8_MMA(ai, bj, At, Bt) do { __builtin_amdgcn_s_setprio(1); _Pragma("unroll") for (int m = 0; m < 4; ++m) _Pragma("unroll") for (int n = 0; n < 2; ++n) _Pragma("unroll") for (int k = 0; k < 2; ++k) \
        acc[ai][bj][m][n] = __builtin_amdgcn_mfma_f32_16x16x32_bf16(Bt[n][k], At[m][k], acc[ai][bj][m][n], 0, 0, 0); __builtin_amdgcn_s_setprio(0); } while (0)
#define PG8_WAIT_V(n) asm volatile("s_waitcnt vmcnt(" #n ")" ::: "memory")
#define PG8_WAIT_L(n) asm volatile("s_waitcnt lgkmcnt(" #n ")" ::: "memory")
#define PG8_BAR __builtin_amdgcn_s_barrier()
#define PG8_SCHED __builtin_amdgcn_sched_barrier(0)
    Unit cur, nxt; int ui = 0;
    if (!S.next(0, cur)) return;
    f32x4 acc[2][2][4][2];
#pragma unroll
    for (int a = 0; a < 2; ++a)
#pragma unroll
        for (int b = 0; b < 2; ++b)
#pragma unroll
            for (int m = 0; m < 4; ++m)
#pragma unroll
                for (int n = 0; n < 2; ++n) acc[a][b][m][n] = (f32x4){0.f, 0.f, 0.f, 0.f};
    bf16x8 At[4][2], B0[2][2], B1[2][2];
    const char* cA = (const char*)g.A + (size_t)cur.pm * tstep; const char* cB = (const char*)g.Bt + (size_t)cur.pn * tstep;
    S.a_ready(cur);
    PG8_STAGE(PG8_SB(0, 0), cB, voffB); PG8_STAGE(PG8_SA(0, 0), cA, voffA); PG8_STAGE(PG8_SB(0, 1), cB + hstep, voffB); PG8_STAGE(PG8_SA(0, 1), cA + hstep, voffA);
    if (wr == 1) PG8_BAR;
    PG8_WAIT_V(4); PG8_BAR;
    PG8_STAGE(PG8_SB(1, 0), cB + kstep, voffB); PG8_STAGE(PG8_SA(1, 0), cA + kstep, voffA); PG8_STAGE(PG8_SB(1, 1), cB + hstep + kstep, voffB);
    PG8_WAIT_V(6); PG8_BAR;
    for (;;) {
        const bool has_next = S.next(ui + 1, nxt);
        const char* nA = has_next ? (const char*)g.A + (size_t)nxt.pm * tstep : cA; const char* nB = has_next ? (const char*)g.Bt + (size_t)nxt.pn * tstep : cB;
        for (int t = 0; t < nt; t += 2) {
            const bool last = (t == nt - 2);
            const char* a1 = cA + (size_t)(t + 1) * kstep;
            const char* a2 = last ? nA : cA + (size_t)(t + 2) * kstep; const char* b2 = last ? nB : cB + (size_t)(t + 2) * kstep;
            const char* a3 = a2 + kstep; const char* b3 = b2 + kstep;
            if (last && has_next) S.a_ready(nxt);
            PG8_LDB(B0, 0, 0); PG8_SCHED; PG8_LDA(At, 0, 0); PG8_STAGE(PG8_SA(1, 1), a1 + hstep, voffA);
            PG8_WAIT_L(8); PG8_BAR; PG8_WAIT_L(0); PG8_MMA(0, 0, At, B0); PG8_BAR; PG8_SCHED;
            PG8_LDB(B1, 0, 1); PG8_STAGE(PG8_SB(0, 0), b2, voffB);
            PG8_BAR; PG8_WAIT_L(0); PG8_MMA(0, 1, At, B1); PG8_BAR;
            PG8_LDA(At, 0, 1); PG8_STAGE(PG8_SA(0, 0), a2, voffA);
            PG8_BAR; PG8_WAIT_L(0); PG8_MMA(1, 0, At, B0); PG8_BAR; PG8_SCHED;
            PG8_STAGE(PG8_SB(0, 1), b2 + hstep, voffB);
            PG8_WAIT_V(6); PG8_BAR; PG8_MMA(1, 1, At, B1); PG8_BAR;
            PG8_LDB(B0, 1, 0); PG8_SCHED; PG8_LDA(At, 1, 0); PG8_STAGE(PG8_SA(0, 1), a2 + hstep, voffA);
            PG8_WAIT_L(8); PG8_BAR; PG8_WAIT_L(0); PG8_MMA(0, 0, At, B0); PG8_BAR; PG8_SCHED;
            PG8_LDB(B1, 1, 1); PG8_STAGE(PG8_SB(1, 0), b3, voffB);
            PG8_BAR; PG8_WAIT_L(0); PG8_MMA(0, 1, At, B1); PG8_BAR;
            PG8_LDA(At, 1, 1); PG8_STAGE(PG8_SA(1, 0), a3, voffA);
            PG8_BAR; PG8_WAIT_L(0); PG8_MMA(1, 0, At, B0); PG8_BAR; PG8_SCHED;
            PG8_STAGE(PG8_SB(1, 1), b3 + hstep, voffB);
            PG8_WAIT_V(6); PG8_BAR; PG8_MMA(1, 1, At, B1); PG8_BAR;
        }
        if constexpr (!Epi::AFTER_DRAIN) { E(acc, cur, wr, wc, fr, fq); S.done(cur); }
        if (!has_next) break;
#pragma unroll
        for (int a = 0; a < 2; ++a)
#pragma unroll
            for (int b = 0; b < 2; ++b)
#pragma unroll
                for (int m = 0; m < 4; ++m)
#pragma unroll
                    for (int n = 0; n < 2; ++n) acc[a][b][m][n] = (f32x4){0.f, 0.f, 0.f, 0.f};
        cur = nxt; cA = nA; cB = nB; ++ui;
    }
    PG8_WAIT_V(0);
    if (wr == 0) PG8_BAR;
    PG8_BAR;
    if constexpr (Epi::AFTER_DRAIN) { E.fused(acc, cur, wr, wc, fr, fq, lds, wid, lane); S.done(cur); }
#undef PG8_SA
#undef PG8_SB
#undef PG8_STAGE
#undef PG8_LDA
#undef PG8_LDB
#undef PG8_MMA
#undef PG8_WAIT_V
#undef PG8_WAIT_L
#undef PG8_BAR
#undef PG8_SCHED
}
}
using pg8::f32x4; using pg8::bf16x8; using pg8::Unit;

__device__ __forceinline__ void load_rinv(const float* ss, int row0, int fq, float (&rinv)[2][4]) {
#pragma unroll
    for (int ai = 0; ai < 2; ++ai)
#pragma unroll
        for (int m = 0; m < 4; ++m) {
            const int row = row0 + ai * 128 + m * 16;
            const f32x4* q = (const f32x4*)(ss + (size_t)row * 32 + fq * 8);
            const f32x4 a = q[0], b = q[1];
            float s = (a[0] + a[1]) + (a[2] + a[3]) + (b[0] + b[1]) + (b[2] + b[3]);
            s += swz16(s); s = sum32(s);
            rinv[ai][m] = rsqrtf(s * (1.0f / 2048.0f) + 1e-6f);
        }
}
struct EpiZ {
    static constexpr bool PERM = true, AFTER_DRAIN = false;
    u16* Z; const float* ss;
    __device__ __forceinline__ void operator()(const f32x4 (&acc)[2][2][4][2], const Unit& u, int wr, int wc, int fr, int fq) const {
        const int row0 = u.pm * 256 + wr * 64 + fr, col0 = u.pn * 256 + wc * 32 + 8 * fq;
        float rinv[2][4]; load_rinv(ss, row0, fq, rinv);
#pragma unroll
        for (int ai = 0; ai < 2; ++ai)
#pragma unroll
            for (int m = 0; m < 4; ++m) {
                const int row = row0 + ai * 128 + m * 16; const float ri = rinv[ai][m];
#pragma unroll
                for (int bj = 0; bj < 2; ++bj) {
                    const int c0 = col0 + bj * 128;
                    if (c0 < NIN) {
                        const f32x4 v0 = acc[ai][bj][m][0] * ri, v1 = acc[ai][bj][m][1] * ri;
                        u32x4 o; o.x = pack2(v0[0], v0[1]); o.y = pack2(v0[2], v0[3]); o.z = pack2(v1[0], v1[1]); o.w = pack2(v1[2], v1[3]);
                        *(u32x4*)(Z + (size_t)row * NIN + c0) = o;
                    }
                }
            }
    }
};
struct EpiUp {
    static constexpr bool PERM = true, AFTER_DRAIN = false;
    u16* H; const float* ss;
    __device__ __forceinline__ void operator()(const f32x4 (&acc)[2][2][4][2], const Unit& u, int wr, int wc, int fr, int fq) const {
        const int row0 = u.pm * 256 + wr * 64 + fr, col0 = u.pn * 256 + wc * 32 + 8 * fq;
        float rinv[2][4]; load_rinv(ss, row0, fq, rinv);
#pragma unroll
        for (int ai = 0; ai < 2; ++ai)
#pragma unroll
            for (int m = 0; m < 4; ++m) {
                const int row = row0 + ai * 128 + m * 16; const float ri = rinv[ai][m];
#pragma unroll
                for (int bj = 0; bj < 2; ++bj) {
                    const int c0 = col0 + bj * 128;
                    float v[8];
#pragma unroll
                    for (int e = 0; e < 4; ++e) { float a = fmaxf(acc[ai][bj][m][0][e] * ri, 0.f), b = fmaxf(acc[ai][bj][m][1][e] * ri, 0.f); v[e] = a * a; v[4 + e] = b * b; }
                    u32x4 o; o.x = pack2(v[0], v[1]); o.y = pack2(v[2], v[3]); o.z = pack2(v[4], v[5]); o.w = pack2(v[6], v[7]);
                    *(u32x4*)(H + (size_t)row * DFF + c0) = o;
                }
            }
    }
};
struct EpiPl {
    static constexpr bool PERM = true, AFTER_DRAIN = false;
    u16* PL;
    __device__ __forceinline__ void operator()(const f32x4 (&acc)[2][2][4][2], const Unit& u, int wr, int wc, int fr, int fq) const {
        const int row0 = u.pm * 256 + wr * 64 + fr, col0 = u.pn * 256 + wc * 32 + 8 * fq;
#pragma unroll
        for (int ai = 0; ai < 2; ++ai)
#pragma unroll
            for (int m = 0; m < 4; ++m) {
                const int row = row0 + ai * 128 + m * 16;
#pragma unroll
                for (int bj = 0; bj < 2; ++bj) {
                    const int c0 = col0 + bj * 128;
                    const f32x4 v0 = acc[ai][bj][m][0], v1 = acc[ai][bj][m][1];
                    u32x4 o; o.x = pack2(v0[0], v0[1]); o.y = pack2(v0[2], v0[3]); o.z = pack2(v1[0], v1[1]); o.w = pack2(v1[2], v1[3]);
                    *(u32x4*)(PL + (size_t)row * DM + c0) = o;
                }
            }
    }
};
struct EpiRes {
    static constexpr bool PERM = true, AFTER_DRAIN = false;
    const float* res; float* out; u16* hb; float* ss_out;
    __device__ __forceinline__ void operator()(const f32x4 (&acc)[2][2][4][2], const Unit& u, int wr, int wc, int fr, int fq) const {
        const int row0 = u.pm * 256 + wr * 64 + fr, col0 = u.pn * 256 + wc * 32 + 8 * fq;
#pragma unroll
        for (int ai = 0; ai < 2; ++ai)
#pragma unroll
            for (int m = 0; m < 4; ++m) {
                const int row = row0 + ai * 128 + m * 16; float sq = 0.f;
#pragma unroll
                for (int bj = 0; bj < 2; ++bj) {
                    const size_t off = (size_t)row * DM + col0 + bj * 128;
                    const f32x4 r0 = *(const f32x4*)(res + off), r1 = *(const f32x4*)(res + off + 4);
                    const f32x4 v0 = acc[ai][bj][m][0] + r0, v1 = acc[ai][bj][m][1] + r1;
                    *(f32x4*)(out + off) = v0; *(f32x4*)(out + off + 4) = v1;
                    u32x4 o; o.x = pack2(v0[0], v0[1]); o.y = pack2(v0[2], v0[3]); o.z = pack2(v1[0], v1[1]); o.w = pack2(v1[2], v1[3]);
                    *(u32x4*)(hb + off) = o;
                    sq += v0[0] * v0[0] + v0[1] * v0[1] + v0[2] * v0[2] + v0[3] * v0[3] + v1[0] * v1[0] + v1[1] * v1[1] + v1[2] * v1[2] + v1[3] * v1[3];
                }
                sq += swz16(sq); sq = sum32(sq);
                if (fq == 0) ss_out[(size_t)row * 32 + u.pn * 4 + wc] = sq;
            }
    }
};
template <bool LAST> struct EpiGate {
    static constexpr bool PERM = true, AFTER_DRAIN = false;
    const u16* PL; float* out; u16* hb; const float* ss; float* ss_out;
    __device__ __forceinline__ void operator()(const f32x4 (&acc)[2][2][4][2], const Unit& u, int wr, int wc, int fr, int fq) const {
        const int row0 = u.pm * 256 + wr * 64 + fr, col0 = u.pn * 256 + wc * 32 + 8 * fq;
        float rinv[2][4]; load_rinv(ss, row0, fq, rinv);
#pragma unroll
        for (int ai = 0; ai < 2; ++ai)
#pragma unroll
            for (int m = 0; m < 4; ++m) {
                const int row = row0 + ai * 128 + m * 16; const float ri = rinv[ai][m]; float sq = 0.f;
#pragma unroll
                for (int bj = 0; bj < 2; ++bj) {
                    const size_t off = (size_t)row * DM + col0 + bj * 128;
                    const f32x4 h0 = *(const f32x4*)(out + off), h1 = *(const f32x4*)(out + off + 4);
                    const u32x4 pv = *(const u32x4*)(PL + off);
                    const float pl[8] = {bflo(pv.x), bfhi(pv.x), bflo(pv.y), bfhi(pv.y), bflo(pv.z), bfhi(pv.z), bflo(pv.w), bfhi(pv.w)};
                    f32x4 v0, v1;
#pragma unroll
                    for (int e = 0; e < 4; ++e) {
                        v0[e] = h0[e] + pl[e] * sigmoidf_(acc[ai][bj][m][0][e] * ri);
                        v1[e] = h1[e] + pl[4 + e] * sigmoidf_(acc[ai][bj][m][1][e] * ri);
                    }
                    *(f32x4*)(out + off) = v0; *(f32x4*)(out + off + 4) = v1;
                    u32x4 o; o.x = pack2(v0[0], v0[1]); o.y = pack2(v0[2], v0[3]); o.z = pack2(v1[0], v1[1]); o.w = pack2(v1[2], v1[3]);
                    if (!LAST) *(u32x4*)(hb + off) = o;
                    sq += v0[0] * v0[0] + v0[1] * v0[1] + v0[2] * v0[2] + v0[3] * v0[3] + v1[0] * v1[0] + v1[1] * v1[1] + v1[2] * v1[2] + v1[3] * v1[3];
                }
                sq += swz16(sq); sq = sum32(sq);
                if (!LAST && fq == 0) ss_out[(size_t)row * 32 + u.pn * 4 + wc] = sq;
            }
    }
};
template <class Epi> __device__ __forceinline__ void run_gemm(int wv, LAS unsigned char* lds, const u16* A, const u16* Bt, int M, int N, int K, const Epi& E) {
    pg8::Gemm g; g.A = A; g.Bt = Bt; g.M = M; g.N = N; g.K = K;
    pg8::StaticOrder S; S.init(M, N, (int)gridDim.x, (int)blockIdx.x);
    pg8::gemm_phase<Epi, pg8::StaticOrder>(wv, lds, g, S, E);
}

__device__ __forceinline__ void conv_tile(int wv, const float* src, int K, int N, const float* gs, u16* dst, int k0, int n0, LAS u16* T) {
    const int tid = otid();
    {
        const int r = tid >> 4, c4 = (tid & 15) * 4;
#pragma unroll
        for (int ps = 0; ps < 2; ++ps) {
            const int k = k0 + r + 32 * ps;
            const float4 v = *(const float4*)(src + (size_t)k * N + n0 + c4);
            const float g = gs ? gs[k] : 1.0f;
            T[(c4 + 0) * 66 + r + 32 * ps] = f2bf(v.x * g); T[(c4 + 1) * 66 + r + 32 * ps] = f2bf(v.y * g);
            T[(c4 + 2) * 66 + r + 32 * ps] = f2bf(v.z * g); T[(c4 + 3) * 66 + r + 32 * ps] = f2bf(v.w * g);
        }
    }
    __syncthreads();
    {
        const int n = tid >> 3, kc = (tid & 7) * 8;
        const LAS unsigned* s = (const LAS unsigned*)(T + n * 66 + kc);
        u32x4 o; o.x = s[0]; o.y = s[1]; o.z = s[2]; o.w = s[3];
        *(u32x4*)(dst + (size_t)(n0 + n) * K + k0 + kc) = o;
    }
    __syncthreads();
}
struct ConvTD { const float* src; const float* gs; u16* dst; int K, N, k0, n0; };
template <class Dec> __device__ __forceinline__ void conv_stream(int wv, int first, int count, int stride, LAS u16* T, Dec dec) {
    const int tid = otid();
    const int r = tid >> 4, c4 = (tid & 15) * 4, n = tid >> 3, kc = (tid & 7) * 8;
    int it = first;
    if (it < count) {
        ConvTD cur = dec(it);
        f32x4 v0 = __builtin_nontemporal_load((const f32x4*)(cur.src + (size_t)(cur.k0 + r) * cur.N + cur.n0 + c4)), v1 = __builtin_nontemporal_load((const f32x4*)(cur.src + (size_t)(cur.k0 + r + 32) * cur.N + cur.n0 + c4));
        float g0 = cur.gs ? cur.gs[cur.k0 + r] : 1.0f, g1 = cur.gs ? cur.gs[cur.k0 + r + 32] : 1.0f;
        int par = 0;
        for (;;) {
            LAS u16* Tb = T + par * 4224;
            Tb[(c4 + 0) * 66 + r] = f2bf(v0.x * g0); Tb[(c4 + 1) * 66 + r] = f2bf(v0.y * g0); Tb[(c4 + 2) * 66 + r] = f2bf(v0.z * g0); Tb[(c4 + 3) * 66 + r] = f2bf(v0.w * g0);
            Tb[(c4 + 0) * 66 + r + 32] = f2bf(v1.x * g1); Tb[(c4 + 1) * 66 + r + 32] = f2bf(v1.y * g1); Tb[(c4 + 2) * 66 + r + 32] = f2bf(v1.z * g1); Tb[(c4 + 3) * 66 + r + 32] = f2bf(v1.w * g1);
            const int nx = it + stride; const bool has = nx < count;
            ConvTD nd = cur;
            if (has) {
                nd = dec(nx);
                v0 = __builtin_nontemporal_load((const f32x4*)(nd.src + (size_t)(nd.k0 + r) * nd.N + nd.n0 + c4)); v1 = __builtin_nontemporal_load((const f32x4*)(nd.src + (size_t)(nd.k0 + r + 32) * nd.N + nd.n0 + c4));
                g0 = nd.gs ? nd.gs[nd.k0 + r] : 1.0f; g1 = nd.gs ? nd.gs[nd.k0 + r + 32] : 1.0f;
            }
            __syncthreads();
            {
                const LAS unsigned* sp = (const LAS unsigned*)(Tb + n * 66 + kc);
                u32x4 o; o.x = sp[0]; o.y = sp[1]; o.z = sp[2]; o.w = sp[3];
                *(u32x4*)(cur.dst + (size_t)(cur.n0 + n) * cur.K + cur.k0 + kc) = o;
            }
            if (!has) break;
            cur = nd; it = nx; par ^= 1;
        }
    }
    __syncthreads();
}
__device__ __forceinline__ void phase_conv(PC p, int wv, int L, LAS unsigned char* lds, int part) {
    LAS u16* T = (LAS u16*)lds;
    const int tid = otid();
    if (part == 1) {
        conv_stream(wv, (int)blockIdx.x, 9344, (int)gridDim.x, T, [&](int it) {
            ConvTD d; int id;
            if (it < 4096) { id = it; d.src = p->w_up + (size_t)L * DM * DFF; d.K = DM; d.N = DFF; d.gs = p->mlp_norm_g + L * DM; d.dst = p->Wt_up; }
            else if (it < 8192) { id = it - 4096; d.src = p->w_down + (size_t)L * DFF * DM; d.K = DFF; d.N = DM; d.gs = nullptr; d.dst = p->Wt_down; }
            else if (it < 9216) { id = it - 8192; d.src = p->w_gate + (size_t)L * DM * DM; d.K = DM; d.N = DM; d.gs = p->ple_norm_g + L * DM; d.dst = p->Wt_gate; }
            else { id = it - 9216; d.src = p->w_ple + (size_t)L * 256 * DM; d.K = 256; d.N = DM; d.gs = nullptr; d.dst = p->Wt_ple; }
            const int ntn = d.N / 64; d.k0 = (id / ntn) * 64; d.n0 = (id % ntn) * 64;
            return d; });
        return;
    }
    const int nW = 4288, nPad = 64, nP = 1024, nX = (L == 0) ? 2048 : 0;
    conv_stream(wv, (int)blockIdx.x, nW, (int)gridDim.x, T, [&](int it) {
        ConvTD d; int id;
        if (it < 3264) { id = it; d.src = p->w_in + (size_t)L * DM * NIN; d.K = DM; d.N = NIN; d.gs = p->mix_norm_g + L * DM; d.dst = p->Wt_in; }
        else { id = it - 3264; d.src = p->w_out + (size_t)L * DM * DM; d.K = DM; d.N = DM; d.gs = nullptr; d.dst = p->Wt_out; }
        const int ntn = d.N / 64; d.k0 = (id / ntn) * 64; d.n0 = (id % ntn) * 64;
        return d; });
    const int total = nW + nPad + nP + nX;
    for (int it = nW + blockIdx.x; it < total; it += gridDim.x) {
        if (it < nW + nPad) {
            const int i = (it - nW) * 512 + tid;
            u32x4 zz; zz.x = zz.y = zz.z = zz.w = 0u;
            ((u32x4*)(p->Wt_in + (size_t)NIN * DM))[i] = zz;
        } else if (it < nW + nPad + nP) {
            const size_t i = ((size_t)(it - nW - nPad) * 512 + tid) * 8;
            const float* s = p->p + (size_t)L * T_TOK * 256 + i;
            const float4 a = *(const float4*)s, b = *(const float4*)(s + 4);
            u32x4 o; o.x = pack2(a.x, a.y); o.y = pack2(a.z, a.w); o.z = pack2(b.x, b.y); o.w = pack2(b.z, b.w);
            *(u32x4*)(p->pb + i) = o;
        } else {
            const int row = (it - nW - nPad - nP) * 8 + (tid >> 6), lane = tid & 63;
            const float* s = p->x + (size_t)row * DM; u16* d = p->mix + (size_t)row * DM;
            float sq = 0.f;
#pragma unroll
            for (int i = 0; i < 8; ++i) {
                const float4 v = *(const float4*)(s + (i * 64 + lane) * 4);
                sq += v.x * v.x + v.y * v.y + v.z * v.z + v.w * v.w;
                u32x2 o; o.x = pack2(v.x, v.y); o.y = pack2(v.z, v.w);
                *(u32x2*)(d + (i * 64 + lane) * 4) = o;
            }
            sq = wave_sum(sq);
            if (lane < 32) p->ss0[(size_t)row * 32 + lane] = (lane == 0) ? sq : 0.f;
        }
    }
}
__device__ __forceinline__ f32x16 mfma32(bf16x8 a, bf16x8 b, f32x16 c) { return __builtin_amdgcn_mfma_f32_32x32x16_bf16(a, b, c, 0, 0, 0); }
template <int K> __device__ __forceinline__ f32x16 mm32(const LAS unsigned char* act, int pitchB, const float* wcol, int ldw, int j, int g) {
    f32x16 acc;
#pragma unroll
    for (int r = 0; r < 16; ++r) acc[r] = 0.f;
    float wn[8], wc[8];
#pragma unroll
    for (int e = 0; e < 8; ++e) wn[e] = wcol[(size_t)(8 * g + e) * ldw];
#pragma unroll
    for (int ks = 0; ks < K / 16; ++ks) {
#pragma unroll
        for (int e = 0; e < 8; ++e) wc[e] = wn[e];
        if (ks + 1 < K / 16) {
#pragma unroll
            for (int e = 0; e < 8; ++e) wn[e] = wcol[(size_t)(16 * (ks + 1) + 8 * g + e) * ldw];
        }
        const bf16x8 a = *(const LAS bf16x8*)(act + j * pitchB + ks * 32 + g * 16);
        u32x4 q; q.x = pack2(wc[0], wc[1]); q.y = pack2(wc[2], wc[3]); q.z = pack2(wc[4], wc[5]); q.w = pack2(wc[6], wc[7]);
        acc = mfma32(a, __builtin_bit_cast(bf16x8, q), acc);
    }
    return acc;
}
constexpr int ZA = 0, ZH = 1536, ZC = 4096, ZR = 4608;
template <int W> __device__ __forceinline__ void pool_diff(const float (&zw)[47], const bool (&ok)[47], float (&df)[32]) {
#pragma unroll
    for (int t = 0; t < 32; ++t) {
        float s = 0.f, c = 0.f;
#pragma unroll
        for (int o = -(W / 2); o <= (W - W / 2 - 1); ++o) { s += zw[8 + t + o]; c += ok[8 + t + o] ? 1.f : 0.f; }
        df[t] = s / c - zw[8 + t];
    }
}
__device__ __forceinline__ void rwkv_prep_item(PC p, int wv, int L, int tb, LAS unsigned char* lds) {
    const int tid = otid(); const u16* z = p->R0;
    const int tok0 = tb * 32;
    LAS unsigned char* actb = lds;
    LAS float* outL = (LAS float*)(lds + 20480);
    {
        const int t = tid >> 4, c4 = (tid & 15) * 4, tok = tok0 + t, sq = tok & (SEQ - 1);
#pragma unroll
        for (int which = 0; which < 4; ++which) {
            const int rc = 1536 + which * 64 + c4;
            const u16* zc = z + (size_t)tok * NIN + ZR + rc;
            const float* mu0 = p->r_mu + (size_t)L * 3840 + rc; const float* mu1 = mu0 + 1920;
#pragma unroll
            for (int e = 0; e < 4; ++e) {
                const float zt = bf2f(zc[e]);
                const float zp = sq > 0 ? bf2f(zc[e - NIN]) : 0.f, zn = sq < SEQ - 1 ? bf2f(zc[e + NIN]) : 0.f;
                float v = zt + mu0[e] * (zp - zt) + mu1[e] * (zn - zt);
                if (which < 2) v = tanhf(v);
                *(LAS u16*)(actb + which * 4608 + t * 144 + (c4 + e) * 2) = f2bf(v);
            }
        }
    }
    __syncthreads();
    const int col = tid;
    float kk_[32], k_[32];
    {
        const float mu0r = p->r_mu[(size_t)L * 3840 + col], mu1r = p->r_mu[(size_t)L * 3840 + 1920 + col];
        const float mu0k = p->r_mu[(size_t)L * 3840 + 512 + col], mu1k = p->r_mu[(size_t)L * 3840 + 1920 + 512 + col];
        const float mu0v = p->r_mu[(size_t)L * 3840 + 1024 + col], mu1v = p->r_mu[(size_t)L * 3840 + 1920 + 1024 + col];
        const float kkg = p->r_kk[L * 512 + col];
        const int s0 = tok0 & (SEQ - 1);
        const u16* zc = z + (size_t)tok0 * NIN + ZR + col;
        float zr_[34], zk_[34], zv_[34];
#pragma unroll
        for (int i = 0; i < 34; ++i) {
            const int sq = s0 - 1 + i; const bool ok = (sq >= 0) && (sq < SEQ);
            const u16* q = zc + (long)(i - 1) * NIN;
            zr_[i] = ok ? bf2f(q[0]) : 0.f; zk_[i] = ok ? bf2f(q[512]) : 0.f; zv_[i] = ok ? bf2f(q[1024]) : 0.f;
        }
        _Float16* dr = p->ra[0] + (size_t)tok0 * 512 + col; _Float16* dk = p->ra[1] + (size_t)tok0 * 512 + col; _Float16* dv = p->ra[2] + (size_t)tok0 * 512 + col;
#pragma unroll
        for (int t = 0; t < 32; ++t) {
            const float rp = zr_[t], rc = zr_[t + 1], rn = zr_[t + 2];
            const float kp = zk_[t], kc = zk_[t + 1], kn = zk_[t + 2];
            const float vp = zv_[t], vc = zv_[t + 1], vn = zv_[t + 2];
            const float r = rc + mu0r * (rp - rc) + mu1r * (rn - rc);
            const float k = kc + mu0k * (kp - kc) + mu1k * (kn - kc);
            const float v = vc + mu0v * (vp - vc) + mu1v * (vn - vc);
            float kk = k * kkg;
            kk *= rsqrtf(wave_sum(kk * kk) + 1e-12f);
            k_[t] = k; kk_[t] = kk;
            dr[(size_t)t * 512] = (_Float16)r; dk[(size_t)t * 512] = (_Float16)kk; dv[(size_t)t * 512] = (_Float16)v;
        }
    }
    const float kag = p->r_ka[L * 512 + col];
#pragma unroll
    for (int which = 0; which < 4; ++which) {
        const int d = which & 1;
        {
            const int lane = tid & 63, g = lane >> 5, j = lane & 31, wave = tid >> 6;
            const float* Wb = (which < 2 ? p->r_w2 : p->r_a2) + ((size_t)L * 2 + d) * 64 * 512;
#pragma unroll 1
            for (int i = 0; i < 2; ++i) {
                const int n0 = (2 * wave + i) * 32;
                const f32x16 c = mm32<64>(actb + which * 4608, 144, Wb + n0 + j, 512, j, g);
#pragma unroll
                for (int r = 0; r < 16; ++r) outL[((r >> 2) * 8 + 4 * g + (r & 3)) * 512 + n0 + j] = c[r];
            }
        }
        __syncthreads();
        float acc[32];
#pragma unroll
        for (int t = 0; t < 32; ++t) acc[t] = outL[t * 512 + col];
        const float bias = (which < 2 ? p->r_w0 : p->r_a0)[((size_t)L * 2 + d) * 512 + col];
        if (which < 2) {
            _Float16* dw = p->ra[3 + 3 * d] + (size_t)tok0 * 512 + col;
#pragma unroll
            for (int t = 0; t < 32; ++t) dw[(size_t)t * 512] = (_Float16)__expf(-0.6065306597126334f * sigmoidf_(bias + acc[t]));
        } else {
            _Float16* db = p->ra[4 + 3 * d] + (size_t)tok0 * 512 + col; _Float16* de = p->ra[5 + 3 * d] + (size_t)tok0 * 512 + col;
#pragma unroll
            for (int t = 0; t < 32; ++t) {
                const float a = sigmoidf_(bias + acc[t]);
                db[(size_t)t * 512] = (_Float16)(kk_[t] * a);
                de[(size_t)t * 512] = (_Float16)(k_[t] * (1.0f + (a - 1.0f) * kag));
            }
        }
        __syncthreads();
    }
}
__device__ __forceinline__ void phase_prep(PC p, int wv, int L, LAS unsigned char* lds) {
    const int tid = otid();
    u16* z = p->R0;
    const int nQK = 512, nLora = 512, nPool = 512, nHg = 1024;
    const int total = nQK + nLora + nPool + nHg;
    for (int it = blockIdx.x; it < total; it += gridDim.x) {
        if (it < nQK) {
            const int tok = it * 32 + (tid >> 4), grp = tid & 15;
            u16* q = z + (size_t)tok * NIN + grp * 64;
            const float* gn = (grp < 8 ? p->a_qnorm : p->a_knorm) + L * 64;
            const float sc = grp < 8 ? 0.125f * LOG2E : 1.0f;
            u32x4 v[8]; float ss = 0.f;
#pragma unroll
            for (int i = 0; i < 8; ++i) {
                v[i] = ((const u32x4*)q)[i];
                const float a0 = bflo(v[i].x), a1 = bfhi(v[i].x), a2 = bflo(v[i].y), a3 = bfhi(v[i].y), a4 = bflo(v[i].z), a5 = bfhi(v[i].z), a6 = bflo(v[i].w), a7 = bfhi(v[i].w);
                ss += a0 * a0 + a1 * a1 + a2 * a2 + a3 * a3 + a4 * a4 + a5 * a5 + a6 * a6 + a7 * a7;
            }
            const float ri = rsqrtf(ss * (1.0f / 64.0f) + 1e-6f) * sc;
#pragma unroll
            for (int i = 0; i < 8; ++i) {
                const float* g = gn + i * 8;
                u32x4 o;
                o.x = pack2(bflo(v[i].x) * ri * g[0], bfhi(v[i].x) * ri * g[1]); o.y = pack2(bflo(v[i].y) * ri * g[2], bfhi(v[i].y) * ri * g[3]);
                o.z = pack2(bflo(v[i].z) * ri * g[4], bfhi(v[i].z) * ri * g[5]); o.w = pack2(bflo(v[i].w) * ri * g[6], bfhi(v[i].w) * ri * g[7]);
                ((u32x4*)q)[i] = o;
            }
        } else if (it < nQK + nLora) {
            rwkv_prep_item(p, wv, L, it - nQK, lds);
        } else if (it < nQK + nLora + nPool) {
            const int tb = it - nQK - nLora, tok0 = tb * 32, s0 = tok0 & (SEQ - 1);
            LAS unsigned char* dfb = lds;
            {
                float zw[47]; bool ok[47];
                const u16* zc = z + (size_t)tok0 * NIN + ZC + tid;
#pragma unroll
                for (int i = 0; i < 47; ++i) {
                    const int s = s0 - 8 + i; ok[i] = (s >= 0 && s < SEQ);
                    zw[i] = ok[i] ? bf2f(zc[(long)(i - 8) * NIN]) : 0.f;
                }
                float d[32];
                const int gi = tid >> 7;
                if (gi == 0) pool_diff<2>(zw, ok, d); else if (gi == 1) pool_diff<4>(zw, ok, d); else if (gi == 2) pool_diff<8>(zw, ok, d); else pool_diff<16>(zw, ok, d);
#pragma unroll
                for (int t = 0; t < 32; ++t) *(LAS u16*)(dfb + t * 1040 + tid * 2) = f2bf(d[t]);
            }
            __syncthreads();
            {
                const int lane = tid & 63, g = lane >> 5, j = lane & 31, wave = tid >> 6;
#pragma unroll 1
                for (int i = 0; i < 2; ++i) {
                    const int nt = 2 * wave + i, gi = nt >> 2, d0 = (nt & 3) * 32, ccol = gi * 128 + d0 + j;
                    const f32x16 c = mm32<128>(dfb + gi * 256, 1040, p->c_w + ((size_t)L * 4 + gi) * 128 * 128 + d0 + j, 128, j, g);
                    const float cb = p->c_b[L * 512 + ccol], cs = p->c_scale[L * 512 + ccol];
                    u16* dst = p->mix + (size_t)tok0 * DM + 1024 + ccol;
#pragma unroll
                    for (int r = 0; r < 16; ++r) dst[(size_t)((r >> 2) * 8 + 4 * g + (r & 3)) * DM] = f2bf((c[r] + cb) * cs);
                }
            }
            __syncthreads();
        } else {
            const int id = it - nQK - nLora - nPool, h = id & 3, ch = (id >> 2) & 127, b = id >> 9;
            const int d = tid & 127, qtr = tid >> 7;
            const size_t tok0 = (size_t)b * SEQ + ch * 64 + qtr * 16;
            LAS float* tot = (LAS float*)lds;
            float lb = 0.f;
            if (L == 1) lb = 1.0f / (1.0f + __expf(p->h_lb[h * 128 + d] - p->h_lb[512 + h * 128 + d]));
            u16* zq = z + tok0 * NIN + ZH + h * 128 + d;
            float qs[16], kf[16], kb[16], pf[16], pb[16], lbk[16];
            float sf = 0.f, sb = 0.f;
#pragma unroll
            for (int j = 0; j < 16; ++j) {
                const float q = bf2f(zq[(size_t)j * NIN]), ff = bf2f(zq[(size_t)j * NIN + 512]), fb = bf2f(zq[(size_t)j * NIN + 1024]);
                qs[j] = q * sigmoidf_(q);
                const float gf = lb + (1.f - lb) * sigmoidf_(ff), gb = lb + (1.f - lb) * sigmoidf_(fb);
                kf[j] = (1.f - lb) * sigmoidf_(-ff); kb[j] = (1.f - lb) * sigmoidf_(-fb);
                const float lf = __logf(gf), lbw = __logf(gb);
                sf += lf; sb += lbw; pf[j] = sf; pb[j] = sb; lbk[j] = lbw;
            }
            tot[(0 * 4 + qtr) * 128 + d] = sf; tot[(1 * 4 + qtr) * 128 + d] = sb;
            __syncthreads();
            const float tf0 = tot[0 * 128 + d], tf1 = tot[1 * 128 + d], tf2 = tot[2 * 128 + d], tf3 = tot[3 * 128 + d];
            const float tb0 = tot[4 * 128 + d], tb1 = tot[5 * 128 + d], tb2 = tot[6 * 128 + d], tb3 = tot[7 * 128 + d];
            const float offf = (qtr > 0 ? tf0 : 0.f) + (qtr > 1 ? tf1 : 0.f) + (qtr > 2 ? tf2 : 0.f);
            const float offb = (qtr > 0 ? tb0 : 0.f) + (qtr > 1 ? tb1 : 0.f) + (qtr > 2 ? tb2 : 0.f);
            const float bmidf = tf0 + tf1, blastf = bmidf + tf2 + tf3;
            const float totb = tb0 + tb1 + tb2 + tb3, bmidb = tb2 + tb3;
            u16* qb = p->qmb + tok0 * 512 + h * 128 + d;
#pragma unroll
            for (int j = 0; j < 16; ++j) {
                const float bt = offf + pf[j];
                const float bbt = totb - (offb + pb[j]) + lbk[j];
                zq[(size_t)j * NIN] = f2bf(qs[j] * __expf(bt - bmidf));
                zq[(size_t)j * NIN + 512] = f2bf(kf[j] * __expf(bmidf - bt));
                zq[(size_t)j * NIN + 1024] = f2bf(kb[j] * __expf(bmidb - bbt));
                qb[(size_t)j * 512] = f2bf(qs[j] * __expf(bbt - bmidb));
            }
            if (qtr == 0) {
                float* hvf = p->hv + ((((size_t)0 * 2 + b) * 128 + ch) * 4 + h) * 256;
                float* hvb = p->hv + ((((size_t)1 * 2 + b) * 128 + ch) * 4 + h) * 256;
                hvf[d] = __expf(bmidf); hvf[128 + d] = __expf(blastf - bmidf);
                hvb[d] = __expf(bmidb); hvb[128 + d] = __expf(totb - bmidb);
            }
            __syncthreads();
        }
    }
}
__device__ __forceinline__ bf16x8 tr8(const LAS unsigned char* a0, const LAS unsigned char* a1) {
    const s16x4 lo = __builtin_amdgcn_ds_read_tr16_b64_v4i16((LAS s16x4*)a0);
    const s16x4 hi = __builtin_amdgcn_ds_read_tr16_b64_v4i16((LAS s16x4*)a1);
    bf16x8 r; r[0] = lo[0]; r[1] = lo[1]; r[2] = lo[2]; r[3] = lo[3]; r[4] = hi[0]; r[5] = hi[1]; r[6] = hi[2]; r[7] = hi[3]; return r;
}
__device__ __forceinline__ int t5_bucket(int rel) {
    const int n = rel < 0 ? -rel : rel;
    int v;
    if (n < 8) v = n;
    else { const float nf = (float)n; int lg = 8 + (int)(logf(nf / 8.0f) / 2.772588722239781f * 8.0f); v = lg < 15 ? lg : 15; }
    return (rel > 0 ? 16 : 0) + v;
}

__device__ __forceinline__ void attn_item(PC p, int wv, int L, int item, LAS unsigned char* lds) {
    const int tid = otid(), wave = tid >> 6, lane = tid & 63, g = lane >> 5, j = lane & 31;
    const int m = wv >> 2, qs = wv & 3;
    const int b = item >> 8, h = (item >> 6) & 3, qb = item & 63;
    const size_t tok0 = (size_t)b * SEQ;
    const int q0 = qb * 128 + qs * 32;
    const u16* z = p->R0;
    LAS float* lut = (LAS float*)(lds + 116736);
    float lam, M2; const float lam_init = 0.8f - 0.6f * __expf(-0.3f * (float)L);
    {
        const float* lp = p->a_lambda + L * 256;
        const float s1 = wave_sum(lp[lane] * lp[64 + lane]), s2 = wave_sum(lp[128 + lane] * lp[192 + lane]);
        lam = __expf(s1) - __expf(s2) + lam_init;
        const float gq = wave_max(fabsf(p->a_qnorm[L * 64 + lane])), gk = wave_max(fabsf(p->a_knorm[L * 64 + lane]));
        const float tb = wave_max(fabsf(p->rel_bias[(lane & 31) * 4 + h]));
        M2 = 8.0f * LOG2E * gq * gk + LOG2E * tb;
    }
    if (tid < 257) lut[tid] = p->rel_bias[t5_bucket(tid - 128) * 4 + h] * LOG2E - M2;
    bf16x8 Qf[4];
    {
        const u16* qp = z + (tok0 + q0 + j) * NIN + ZA + h * 128 + m * 64 + 8 * g;
#pragma unroll
        for (int ks = 0; ks < 4; ++ks) Qf[ks] = *(const bf16x8*)(qp + 16 * ks);
    }
    const u16* zb = z + tok0 * NIN + h * 128;
    unsigned ksrc[2], vsrc[2]; int kdst[2]; int vdst[2];
#pragma unroll
    for (int i = 0; i < 2; ++i) {
        const int c = tid + 512 * i;
        { const int mm = c >> 9, key = (c >> 3) & 63, ch = c & 7; ksrc[i] = (unsigned)(key * NIN + 512 + mm * 64 + ch * 8); kdst[i] = mm * 9216 + key * 144 + ch * 16; }
        { const int key = c >> 4, ch = c & 15; vsrc[i] = (unsigned)(key * NIN + 1024 + ch * 8); vdst[i] = 18432 + key * 320 + ch * 16; }
    }
    u32x4 sk[2], sv[2];
#pragma unroll
    for (int i = 0; i < 2; ++i) { sk[i] = *(const u32x4*)(zb + ksrc[i]); sv[i] = *(const u32x4*)(zb + vsrc[i]); }
#pragma unroll
    for (int i = 0; i < 2; ++i) { *(LAS u32x4*)(lds + kdst[i]) = sk[i]; *(LAS u32x4*)(lds + vdst[i]) = sv[i]; }
    __syncthreads();
    const float cpos = lut[256], cneg = lut[0];
    f32x16 O[4];
#pragma unroll
    for (int i = 0; i < 4; ++i)
#pragma unroll
        for (int r = 0; r < 16; ++r) O[i][r] = 0.f;
    float lsum = 0.f;
    const int trq = (lane & 15) >> 2, trp = lane & 3, trh = (lane >> 4) & 1;
    const int troff = trq * 320 + (16 * trh + 4 * trp) * 2;
    bf16x8 p0a, p0b, p1a, p1b;
    auto H1 = [&](int t) {
        const int k0 = t * 64;
        const LAS unsigned char* Kb = lds + (t % 3) * 38912 + m * 9216;
        const int relmin = k0 - (q0 + 31), relmax = k0 + 63 - q0;
        const int mode = relmin >= 128 ? 1 : (relmax <= -128 ? 2 : 0);
        const float c0 = mode == 1 ? cpos : (mode == 2 ? cneg : 0.f);
        f32x16 st0;
        bf16x8 kfa[4];
#pragma unroll
        for (int ks = 0; ks < 4; ++ks) kfa[ks] = *(const LAS bf16x8*)(Kb + j * 144 + ks * 32 + g * 16);
#pragma unroll
        for (int r = 0; r < 16; ++r) st0[r] = c0;
#pragma unroll
        for (int ks = 0; ks < 4; ++ks) st0 = mfma32(kfa[ks], Qf[ks], st0);
#define AT_SOFT(ST, KT, PA, PB) { float pv[16]; \
            if (mode != 0) { _Pragma("unroll") for (int r = 0; r < 16; ++r) pv[r] = __builtin_amdgcn_exp2f(ST[r]); } \
            else { _Pragma("unroll") for (int r = 0; r < 16; ++r) { const int key = k0 + 32 * (KT) + (r >> 2) * 8 + 4 * g + (r & 3); \
                    int rel = key - (q0 + j); rel = rel < -128 ? -128 : (rel > 128 ? 128 : rel); pv[r] = __builtin_amdgcn_exp2f(ST[r] + lut[rel + 128]); } } \
            float ls = 0.f; _Pragma("unroll") for (int r = 0; r < 16; ++r) ls += pv[r]; lsum += ls; \
            u32x4 qa, qb; qa.x = pack2(pv[0], pv[1]); qa.y = pack2(pv[2], pv[3]); qa.z = pack2(pv[4], pv[5]); qa.w = pack2(pv[6], pv[7]); \
            qb.x = pack2(pv[8], pv[9]); qb.y = pack2(pv[10], pv[11]); qb.z = pack2(pv[12], pv[13]); qb.w = pack2(pv[14], pv[15]); \
            PA = __builtin_bit_cast(bf16x8, qa); PB = __builtin_bit_cast(bf16x8, qb); }
#pragma unroll
        for (int ks = 0; ks < 4; ++ks) kfa[ks] = *(const LAS bf16x8*)(Kb + (32 + j) * 144 + ks * 32 + g * 16);
        AT_SOFT(st0, 0, p0a, p0b)
#pragma unroll
        for (int r = 0; r < 16; ++r) st0[r] = c0;
#pragma unroll
        for (int ks = 0; ks < 4; ++ks) st0 = mfma32(kfa[ks], Qf[ks], st0);
        AT_SOFT(st0, 1, p1a, p1b)
#undef AT_SOFT
    };
    auto H2 = [&](int t) {
        const LAS unsigned char* vr0 = lds + (t % 3) * 38912 + 18432 + (4 * g) * 320 + troff;
        bf16x8 va[4], vb[4];
#define AT_TRV(dst, KS) { _Pragma("unroll") for (int dvt = 0; dvt < 4; ++dvt) dst[dvt] = tr8(vr0 + (KS) * 16 * 320 + dvt * 64, vr0 + (KS) * 16 * 320 + 8 * 320 + dvt * 64); }
#define AT_PV(FR, PB_) { _Pragma("unroll") for (int dvt = 0; dvt < 4; ++dvt) O[dvt] = mfma32(FR[dvt], PB_, O[dvt]); }
        AT_TRV(va, 0)
        AT_PV(va, p0a)
        AT_TRV(vb, 1)
        AT_PV(vb, p0b)
        AT_TRV(va, 2)
        AT_PV(va, p1a)
        AT_TRV(vb, 3)
        AT_PV(vb, p1b)
#undef AT_TRV
#undef AT_PV
    };
    for (int t = 0; t <= 128; ++t) {
        const bool more = t + 1 < 128;
        const int nb = ((t + 1) % 3) * 38912;
        const u16* zt = zb + (size_t)(t + 1) * 64 * NIN;
        u32x4 s0, s1;
        if (more) { s0 = *(const u32x4*)(zt + ksrc[0]); s1 = *(const u32x4*)(zt + ksrc[1]); }
        if (m == 1 && t >= 1) H2(t - 1);
        if (m == 0 && t < 128) H1(t);
        if (more) {
            *(LAS u32x4*)(lds + nb + kdst[0]) = s0; *(LAS u32x4*)(lds + nb + kdst[1]) = s1;
            s0 = *(const u32x4*)(zt + vsrc[0]); s1 = *(const u32x4*)(zt + vsrc[1]);
        }
        if (m == 1 && t < 128) H1(t);
        if (m == 0 && t < 128) H2(t);
        if (more) { *(LAS u32x4*)(lds + nb + vdst[0]) = s0; *(LAS u32x4*)(lds + nb + vdst[1]) = s1; }
        __syncthreads();
    }
    lsum = sum32(lsum);
    const float inv = 1.0f / lsum;
    LAS float* Oex = (LAS float*)lds;
    if (m == 1) {
#pragma unroll
        for (int dvt = 0; dvt < 4; ++dvt)
#pragma unroll
            for (int r = 0; r < 16; ++r) { const int dv = 32 * dvt + (r >> 2) * 8 + 4 * g + (r & 3); Oex[(qs * 128 + dv) * 32 + j] = O[dvt][r] * inv; }
    }
    __syncthreads();
    if (m == 0) {
        float ssq = 0.f;
#pragma unroll
        for (int dvt = 0; dvt < 4; ++dvt)
#pragma unroll
            for (int r = 0; r < 16; ++r) { const int dv = 32 * dvt + (r >> 2) * 8 + 4 * g + (r & 3); const float o = O[dvt][r] * inv - lam * Oex[(qs * 128 + dv) * 32 + j]; O[dvt][r] = o; ssq += o * o; }
        ssq = sum32(ssq);
        const float sc = rsqrtf(ssq * (1.0f / 128.0f) + 1e-6f) * (1.0f - lam_init);
        const float* sg = p->a_subln + L * 128;
        u16* dst = p->mix + (tok0 + q0 + j) * DM + h * 128;
#pragma unroll
        for (int dvt = 0; dvt < 4; ++dvt)
#pragma unroll
            for (int r4 = 0; r4 < 4; ++r4) {
                const int dv = 32 * dvt + r4 * 8 + 4 * g;
                u32x2 o; o.x = pack2(O[dvt][4 * r4 + 0] * sc * sg[dv + 0], O[dvt][4 * r4 + 1] * sc * sg[dv + 1]);
                o.y = pack2(O[dvt][4 * r4 + 2] * sc * sg[dv + 2], O[dvt][4 * r4 + 3] * sc * sg[dv + 3]);
                *(u32x2*)(dst + dv) = o;
            }
    }
    __syncthreads();
}
__device__ __forceinline__ void hgrn_item(PC p, int wv, int L, int item, LAS unsigned char* lds) {
    const int tid = otid(), wave = tid >> 6, lane = tid & 63, g = lane >> 5, j = lane & 31;
    const int dir = item >> 3, b = (item >> 2) & 1, h = item & 3;
    const u16* z = p->R0;
    LAS unsigned char* Qt = lds;
    LAS unsigned char* Kt = lds + 17408;
    LAS unsigned char* Vt = lds + 37888;
    LAS unsigned char* Sb = lds + 58368;
    LAS unsigned char* Ab = lds + 99328;
    LAS float* vec = (LAS float*)(lds + 108544);
    const int tt = wave & 1, dvt = wave >> 1;
    const int trq = (lane & 15) >> 2, trp = lane & 3, trh = (lane >> 4) & 1;
    const int troff = (8 * g + trq) * 320 + (16 * trh + 4 * trp) * 2;
    const u16* qsrc; const u16* ksrc; const u16* vsrc; size_t qld;
    if (dir == 0) { qsrc = z + ZH + h * 128; qld = NIN; ksrc = z + ZH + 512 + h * 128; }
    else { qsrc = p->qmb + h * 128; qld = 512; ksrc = z + ZH + 1024 + h * 128; }
    vsrc = z + ZH + 1536 + h * 128;
    u32x4 rq[2], rk[2], rv[2]; float rvec = 0.f;
    auto gload = [&](int c) {
        const size_t tokb = (size_t)b * SEQ + (size_t)c * 64;
#pragma unroll
        for (int i = 0; i < 2; ++i) {
            const int cc = tid + 512 * i, row = cc >> 4, ch = cc & 15;
            rq[i] = *(const u32x4*)(qsrc + (tokb + row) * qld + ch * 8);
            rk[i] = *(const u32x4*)(ksrc + (tokb + row) * NIN + ch * 8);
            rv[i] = *(const u32x4*)(vsrc + (tokb + row) * NIN + ch * 8);
        }
        if (tid < 256) rvec = p->hv[((((size_t)dir * 2 + b) * 128 + c) * 4 + h) * 256 + tid];
    };
    auto lstore = [&]() {
#pragma unroll
        for (int i = 0; i < 2; ++i) {
            const int cc = tid + 512 * i, row = cc >> 4, ch = cc & 15;
            *(LAS u32x4*)(Qt + row * 272 + ch * 16) = rq[i];
            *(LAS u32x4*)(Kt + row * 320 + ch * 16) = rk[i];
            *(LAS u32x4*)(Vt + row * 320 + ch * 16) = rv[i];
        }
        if (tid < 256) vec[tid] = rvec;
    };
    f32x16 S[2];
#pragma unroll
    for (int i = 0; i < 2; ++i)
#pragma unroll
        for (int r = 0; r < 16; ++r) S[i][r] = 0.f;
    gload(dir == 0 ? 0 : 127);
    lstore();
    __syncthreads();
    for (int ci = 0; ci < 128; ++ci) {
        const int c = dir == 0 ? ci : 127 - ci;
        if (ci + 1 < 128) gload(dir == 0 ? ci + 1 : 126 - ci);
#pragma unroll
        for (int i = 0; i < 2; ++i) {
            const int dkb = (2 * tt + i) * 32;
#pragma unroll
            for (int r = 0; r < 16; ++r) {
                const int dk = dkb + (r >> 2) * 8 + 4 * g + (r & 3);
                S[i][r] *= vec[dk];
                *(LAS u16*)(Sb + dk * 320 + (32 * dvt + j) * 2) = f2bf(S[i][r]);
            }
        }
        if (wave < 4) {
            const int at = wave & 1, as = wave >> 1;
            f32x16 acc;
#pragma unroll
            for (int r = 0; r < 16; ++r) acc[r] = 0.f;
#pragma unroll
            for (int ks = 0; ks < 8; ++ks) {
                const bf16x8 a = *(const LAS bf16x8*)(Qt + (32 * at + j) * 272 + ks * 32 + g * 16);
                const bf16x8 bb = *(const LAS bf16x8*)(Kt + (32 * as + j) * 320 + ks * 32 + g * 16);
                acc = mfma32(a, bb, acc);
            }
            const int s = 32 * as + j;
#pragma unroll
            for (int r = 0; r < 16; ++r) {
                const int t = 32 * at + (r >> 2) * 8 + 4 * g + (r & 3);
                const bool keep = dir == 0 ? (s <= t) : (s >= t);
                *(LAS u16*)(Ab + t * 144 + s * 2) = f2bf(keep ? acc[r] : 0.f);
            }
        }
        __syncthreads();
        {
            bf16x8 Vf[4];
#pragma unroll
            for (int ks = 0; ks < 4; ++ks) { const LAS unsigned char* a0 = Vt + ks * 16 * 320 + troff + dvt * 64; Vf[ks] = tr8(a0, a0 + 4 * 320); }
            f32x16 acc;
#pragma unroll
            for (int r = 0; r < 16; ++r) acc[r] = 0.f;
#pragma unroll
            for (int ks = 0; ks < 8; ++ks) {
                const bf16x8 a = *(const LAS bf16x8*)(Qt + (32 * tt + j) * 272 + ks * 32 + g * 16);
                const LAS unsigned char* a0 = Sb + ks * 16 * 320 + troff + dvt * 64;
                acc = mfma32(a, tr8(a0, a0 + 4 * 320), acc);
            }
#pragma unroll
            for (int ks = 0; ks < 4; ++ks) {
                const bf16x8 a = *(const LAS bf16x8*)(Ab + (32 * tt + j) * 144 + ks * 32 + g * 16);
                acc = mfma32(a, Vf[ks], acc);
            }
            {
                const size_t tokb = (size_t)b * SEQ + (size_t)c * 64;
                u16* dst = dir == 0 ? p->mix + tokb * DM + 512 + h * 128 + 32 * dvt + j : p->ob + tokb * 512 + h * 128 + 32 * dvt + j;
                const size_t ld = dir == 0 ? DM : 512;
#pragma unroll
                for (int r = 0; r < 16; ++r) { const int t = 32 * tt + (r >> 2) * 8 + 4 * g + (r & 3); dst[(size_t)t * ld] = f2bf(acc[r]); }
            }
#pragma unroll
            for (int i = 0; i < 2; ++i) {
                const int dkb = (2 * tt + i) * 32;
#pragma unroll
                for (int ks = 0; ks < 4; ++ks) {
                    const LAS unsigned char* a0 = Kt + ks * 16 * 320 + troff + dkb * 2;
                    S[i] = mfma32(tr8(a0, a0 + 4 * 320), Vf[ks], S[i]);
                }
#pragma unroll
                for (int r = 0; r < 16; ++r) { const int dk = dkb + (r >> 2) * 8 + 4 * g + (r & 3); S[i][r] *= vec[128 + dk]; }
            }
        }
        __syncthreads();
        if (ci + 1 < 128) lstore();
        __syncthreads();
    }
}
__device__ __forceinline__ void rwkv_item(PC p, int wv, int L, int item, LAS unsigned char* lds) {
    const int tid = otid(), wave = tid >> 6, lane = tid & 63;
    const int dir = item >> 6, b = (item >> 5) & 1, head = (item >> 2) & 7, quarter = item & 3;
    const int rl = lane >> 4, kq = lane & 15, rowl = wave * 4 + rl;
    float __attribute__((ext_vector_type(2))) SA = {0.f, 0.f}, SB = {0.f, 0.f};
    const _Float16* src[6]; int dsto[6]; int rowi[6];
#pragma unroll
    for (int i = 0; i < 6; ++i) {
        const int q = (tid & 255) + 256 * i, row = (q >> 3) & 31, ch8 = q & 7;
        const _Float16* base = i == 0 ? p->ra[0] : i == 1 ? (dir ? p->ra[6] : p->ra[3]) : i == 2 ? p->ra[1] : i == 3 ? (dir ? p->ra[7] : p->ra[4]) : i == 4 ? p->ra[2] : (dir ? p->ra[8] : p->ra[5]);
        src[i] = base + (size_t)b * SEQ * 512 + head * 64 + ch8 * 8;
        dsto[i] = i * 8192 + row * 256 + ch8 * 32; rowi[i] = row;
    }
    u32x4 st[6];
    auto gload = [&](int c) {
#pragma unroll
        for (int i = 0; i < 6; ++i) { const int step = c * 32 + rowi[i], t = dir == 0 ? step : SEQ - 1 - step; st[i] = *(const u32x4*)(src[i] + (size_t)t * 512); }
    };
    auto lstore = [&](int buf) {
#pragma unroll
        for (int i = 0; i < 6; ++i) {
            typedef _Float16 h2 __attribute__((ext_vector_type(2)));
            f32x4 lo, hi;
            const h2 a0 = __builtin_bit_cast(h2, (unsigned)st[i].x), a1 = __builtin_bit_cast(h2, (unsigned)st[i].y), a2 = __builtin_bit_cast(h2, (unsigned)st[i].z), a3 = __builtin_bit_cast(h2, (unsigned)st[i].w);
            lo[0] = (float)a0[0]; lo[1] = (float)a0[1]; lo[2] = (float)a1[0]; lo[3] = (float)a1[1];
            hi[0] = (float)a2[0]; hi[1] = (float)a2[1]; hi[2] = (float)a3[0]; hi[3] = (float)a3[1];
            LAS unsigned char* d = lds + buf * 49152 + dsto[i];
            *(LAS f32x4*)d = lo; *(LAS f32x4*)(d + 16) = hi;
        }
    };
    if (wv >= 4) { gload(0); lstore(0); }
    __syncthreads();
    for (int c = 0; c < 256; ++c) {
        const int buf = c & 1;
        if (wv >= 4 && c + 1 < 256) gload(c + 1);
        const LAS float* B = (const LAS float*)(lds + buf * 49152);
        LAS float* Yb = (LAS float*)(lds + 98304 + buf * 8192);
        typedef float f32x2 __attribute__((ext_vector_type(2)));
#define RW_LD(S_) { const LAS float* q_ = B + (S_) * 64 + 4 * kq; \
            const f32x4 r_ = *(const LAS f32x4*)q_, w_ = *(const LAS f32x4*)(q_ + 2048), k_ = *(const LAS f32x4*)(q_ + 4096), b_ = *(const LAS f32x4*)(q_ + 6144), e_ = *(const LAS f32x4*)(q_ + 10240); \
            rA = r_.xy; rB = r_.zw; wA = w_.xy; wB = w_.zw; kA = k_.xy; kB = k_.zw; bA = b_.xy; bB = b_.zw; eA = e_.xy; eB = e_.zw; vvn = B[8192 + (S_) * 64 + quarter * 16 + rowl]; }
        if (wv < 4) {
        f32x2 rA, rB, wA, wB, kA, kB, bA, bB, eA, eB; float vvn;
        RW_LD(0)
#pragma unroll
        for (int s = 0; s < 32; ++s) {
            const f32x2 r0 = rA, r1 = rB, w0 = wA, w1 = wB, k0 = kA, k1 = kB, b0 = bA, b1 = bB, e0 = eA, e1 = eB; const float vv = vvn;
            if (s + 1 < 32) RW_LD(s + 1)
            const f32x2 sa2 = SA * k0 + SB * k1;
            const float sa = allreduce16(sa2.x + sa2.y);
            const f32x2 sav = {sa, sa}, vvv = {vv, vv};
            SA = SA * w0 + (vvv * e0 - sav * b0);
            SB = SB * w1 + (vvv * e1 - sav * b1);
            const f32x2 y2 = SA * r0 + SB * r1;
            float yq = y2.x + y2.y;
            yq += dppmov<0xB1>(yq); yq += dppmov<0x4E>(yq);
            Yb[(s * 16 + rowl) * 4 + (kq >> 2)] = yq;
        }
        }
#undef RW_LD
        if (wv >= 4 && c + 1 < 256) lstore(buf ^ 1);
        __syncthreads();
        if (tid >= 256 && tid < 384) {
            const int u = tid - 256, s = u >> 2, r4i = (u & 3) * 4, step = c * 32 + s, t = dir == 0 ? step : SEQ - 1 - step;
            const size_t tok = (size_t)b * SEQ + t;
            f32x4 yv;
#pragma unroll
            for (int i = 0; i < 4; ++i) { const f32x4 q = *(const LAS f32x4*)(Yb + (s * 16 + r4i + i) * 4); yv[i] = (q[0] + q[1]) + (q[2] + q[3]); }
            u32x2 o; o.x = pack2(yv[0], yv[1]); o.y = pack2(yv[2], yv[3]);
            u16* dst = dir == 0 ? p->mix + tok * DM + 1536 + head * 64 + quarter * 16 + r4i : p->yb + tok * 512 + head * 64 + quarter * 16 + r4i;
            *(u32x2*)dst = o;
        }
    }
    __syncthreads();
}

__device__ __forceinline__ void phase_mixer(PC p, int wv, int L, LAS unsigned char* lds) {
    LAS int* slot = (LAS int*)(lds + 131072 - 16);
    for (;;) {
        __syncthreads();
        if (otid() == 0) *slot = (int)atomicAdd(p->ctr + L * 16, 1u);
        __syncthreads();
        const int it = *slot;
        if (it >= 128 + 16 + 512) break;
        if (it < 128) rwkv_item(p, wv, L, it, lds);
        else if (it < 144) hgrn_item(p, wv, L, it - 128, lds);
        else attn_item(p, wv, L, it - 144, lds);
    }
}
__device__ __forceinline__ void phase_post(PC p, int wv, int L, LAS unsigned char* lds) {
    const int tid = otid(), wave = tid >> 6, lane = tid & 63;
    const u16* z = p->R0;
    for (int it = blockIdx.x; it < 512; it += gridDim.x) {
        const int tok0 = it * 32;
        {
            const int t = tid >> 4, sub = tid & 15, hh = sub >> 2, pc = (sub & 3) * 32, tok = tok0 + t;
            u16* mo = p->mix + (size_t)tok * DM + 512 + hh * 128 + pc;
            const u16* ob = p->ob + (size_t)tok * 512 + hh * 128 + pc;
            const u16* gz = z + (size_t)tok * NIN + ZH + 2048 + hh * 128 + pc;
            const float* gn = p->h_onorm + L * 128 + pc;
            float o[32]; float ss = 0.f;
#pragma unroll
            for (int i = 0; i < 4; ++i) {
                const u32x4 a = ((const u32x4*)mo)[i], bq = ((const u32x4*)ob)[i];
                o[8 * i + 0] = bflo(a.x) + bflo(bq.x); o[8 * i + 1] = bfhi(a.x) + bfhi(bq.x); o[8 * i + 2] = bflo(a.y) + bflo(bq.y); o[8 * i + 3] = bfhi(a.y) + bfhi(bq.y);
                o[8 * i + 4] = bflo(a.z) + bflo(bq.z); o[8 * i + 5] = bfhi(a.z) + bfhi(bq.z); o[8 * i + 6] = bflo(a.w) + bflo(bq.w); o[8 * i + 7] = bfhi(a.w) + bfhi(bq.w);
            }
#pragma unroll
            for (int i = 0; i < 32; ++i) ss += o[i] * o[i];
            ss += dppmov<0xB1>(ss); ss += dppmov<0x4E>(ss);
            const float ri = rsqrtf(ss * (1.0f / 128.0f) + 1e-6f);
#pragma unroll
            for (int i = 0; i < 4; ++i) {
                const u32x4 gq = ((const u32x4*)gz)[i];
                const float gv[8] = {bflo(gq.x), bfhi(gq.x), bflo(gq.y), bfhi(gq.y), bflo(gq.z), bfhi(gq.z), bflo(gq.w), bfhi(gq.w)};
                float r[8];
#pragma unroll
                for (int e = 0; e < 8; ++e) r[e] = o[8 * i + e] * ri * gn[8 * i + e] * (gv[e] * sigmoidf_(gv[e]));
                u32x4 w; w.x = pack2(r[0], r[1]); w.y = pack2(r[2], r[3]); w.z = pack2(r[4], r[5]); w.w = pack2(r[6], r[7]);
                ((u32x4*)mo)[i] = w;
            }
        }
        LAS unsigned char* actb = lds;
        LAS float* outL = (LAS float*)(lds + 16384);
        {
            const int t = tid >> 4, c8 = (tid & 15) * 8, tok = tok0 + t, s = tok & (SEQ - 1);
            const u16* zc = z + (size_t)tok * NIN + ZR + 1792 + c8;
            const float* mu0 = p->r_mu + (size_t)L * 3840 + 1792 + c8; const float* mu1 = mu0 + 1920;
#pragma unroll
            for (int e = 0; e < 8; ++e) {
                const float zt = bf2f(zc[e]);
                const float zp = s > 0 ? bf2f(zc[e - NIN]) : 0.f, zn = s < SEQ - 1 ? bf2f(zc[e + NIN]) : 0.f;
                *(LAS u16*)(actb + t * 272 + (c8 + e) * 2) = f2bf(sigmoidf_(zt + mu0[e] * (zp - zt) + mu1[e] * (zn - zt)));
            }
        }
        __syncthreads();
        {
            const int col = tid;
            {
                const int g = lane >> 5, j = lane & 31;
#pragma unroll 1
                for (int i = 0; i < 2; ++i) {
                    const int n0 = (2 * wave + i) * 32;
                    const f32x16 c = mm32<128>(actb, 272, p->r_g2 + (size_t)L * 128 * 512 + n0 + j, 512, j, g);
#pragma unroll
                    for (int r = 0; r < 16; ++r) outL[((r >> 2) * 8 + 4 * g + (r & 3)) * 512 + n0 + j] = c[r];
                }
            }
            __syncthreads();
            float acc[32];
#pragma unroll
            for (int t = 0; t < 32; ++t) acc[t] = outL[t * 512 + col];
            const float rkg = p->r_rk[L * 512 + col], gng = p->r_gn_g[L * 512 + col], gnb = p->r_gn_b[L * 512 + col];
            const size_t base = (size_t)tok0 * 512 + col;
            const _Float16* ar = p->ra[0] + base; const _Float16* av = p->ra[2] + base; const _Float16* aef = p->ra[5] + base; const _Float16* aeb = p->ra[8] + base;
#pragma unroll
            for (int t0 = 0; t0 < 32; t0 += 8) {
                float hr[8], hv[8], hf[8], hb[8], yf[8], yb2[8];
#pragma unroll
                for (int i = 0; i < 8; ++i) {
                    const int t = t0 + i;
                    hr[i] = (float)ar[(size_t)t * 512]; hv[i] = (float)av[(size_t)t * 512]; hf[i] = (float)aef[(size_t)t * 512]; hb[i] = (float)aeb[(size_t)t * 512];
                    yf[i] = bf2f(p->mix[(size_t)(tok0 + t) * DM + 1536 + col]); yb2[i] = bf2f(p->yb[(size_t)(tok0 + t) * 512 + col]);
                }
#pragma unroll
                for (int i = 0; i < 8; ++i) {
                    const int t = t0 + i, tok = tok0 + t;
                    const float r = hr[i], v = hv[i], kef = hf[i], keb = hb[i];
                    const float bonus = wave_sum(r * (0.5f * (kef + keb)) * rkg) * v;
                    const float y = yf[i] + yb2[i];
                    const float mean = wave_sum(y) * (1.0f / 64.0f);
                    const float dy = y - mean;
                    const float var = wave_sum(dy * dy) * (1.0f / 64.0f);
                    const float yn = dy * rsqrtf(var + 64e-5f) * gng + gnb;
                    p->mix[(size_t)tok * DM + 1536 + col] = f2bf((yn + bonus) * acc[t]);
                }
            }
        }
        __syncthreads();
    }
}
constexpr int NPH = 18;
__device__ __forceinline__ void grid_barrier(int wv, unsigned k) {
    PC p = (PC)__builtin_amdgcn_kernarg_segment_ptr();
    asm volatile("" : "+s"(p));
    unsigned* w = p->ctr + 48;
    asm volatile("s_waitcnt vmcnt(0)" ::: "memory");
    __syncthreads();
    if (otid() == 0) {
        __builtin_amdgcn_fence(__ATOMIC_RELEASE, "agent");
        asm volatile("s_waitcnt vmcnt(0)" ::: "memory");
        __hip_atomic_fetch_add(w, 1u, __ATOMIC_RELAXED, __HIP_MEMORY_SCOPE_AGENT);
        const unsigned target = k * gridDim.x;
        while (__hip_atomic_load(w, __ATOMIC_RELAXED, __HIP_MEMORY_SCOPE_AGENT) < target) __builtin_amdgcn_s_sleep(2);
        __builtin_amdgcn_fence(__ATOMIC_ACQUIRE, "agent");
        asm volatile("s_waitcnt vmcnt(0)" ::: "memory");
    }
    __syncthreads();
}
template <int L> __device__ __forceinline__ void run_phase(int wv, int s, LAS unsigned char* lds) {
    PC p = (PC)__builtin_amdgcn_kernarg_segment_ptr();
    asm volatile("" : "+s"(p));
    float* sA = L == 0 ? p->ss0 : p->ss1; float* sB = L == 0 ? p->ss1 : p->ss0;
    __syncthreads();
    if (s == 0) phase_conv(p, wv, L, lds, 0);
    else if (s == 1) { EpiZ e; e.Z = p->R0; e.ss = sA; run_gemm(wv, lds, p->mix, p->Wt_in, T_TOK, NINP, DM, e); }
    else if (s == 2) phase_prep(p, wv, L, lds);
    else if (s == 3) phase_mixer(p, wv, L, lds);
    else if (s == 4) phase_post(p, wv, L, lds);
    else if (s == 5) { phase_conv(p, wv, L, lds, 1); __syncthreads(); EpiRes e; e.res = L == 0 ? p->x : p->out; e.out = p->out; e.hb = p->hb0; e.ss_out = sB; run_gemm(wv, lds, p->mix, p->Wt_out, T_TOK, DM, DM, e); }
    else if (s == 6) { EpiUp e; e.H = p->R0; e.ss = sB; run_gemm(wv, lds, p->hb0, p->Wt_up, T_TOK, DFF, DM, e); }
    else if (s == 7) { EpiRes e; e.res = p->out; e.out = p->out; e.hb = p->hb0; e.ss_out = sA; run_gemm(wv, lds, p->R0, p->Wt_down, T_TOK, DM, DFF, e); }
    else {
        { EpiPl e; e.PL = p->R0; run_gemm(wv, lds, p->pb, p->Wt_ple, T_TOK, DM, 256, e); }
        __syncthreads();
        { EpiGate<(L == 1)> e; e.PL = p->R0; e.out = p->out; e.hb = p->mix; e.ss = sA; e.ss_out = sB; run_gemm(wv, lds, p->hb0, p->Wt_gate, T_TOK, DM, DM, e); }
    }
}
#ifndef FUSED_LAUNCH
#define FUSED_LAUNCH 1
#endif
#if !FUSED_LAUNCH
__global__ __launch_bounds__(512, 2) void mk_phase(Params p_, int ph) {
    extern __shared__ __attribute__((aligned(16))) unsigned char shm[];
    LAS unsigned char* lds = (LAS unsigned char*)shm;
    const int wv = __builtin_amdgcn_readfirstlane((int)(threadIdx.x >> 6));
    if (ph < 9) run_phase<0>(wv, ph, lds); else run_phase<1>(wv, ph - 9, lds);
}
#else
#define MK_PH(L, S, K) run_phase<L>(wv, S, lds); grid_barrier(wv, K);
__global__ __launch_bounds__(512, 2) void mk_forward(Params p_) {
    extern __shared__ __attribute__((aligned(16))) unsigned char shm[];
    LAS unsigned char* lds = (LAS unsigned char*)shm;
    const int wv = __builtin_amdgcn_readfirstlane((int)(threadIdx.x >> 6));
    if (gridDim.x == 0x7fffffffu) cg::this_grid().sync();
    MK_PH(0, 0, 1) MK_PH(0, 1, 2) MK_PH(0, 2, 3) MK_PH(0, 3, 4) MK_PH(0, 4, 5) MK_PH(0, 5, 6) MK_PH(0, 6, 7) MK_PH(0, 7, 8) MK_PH(0, 8, 9)
    MK_PH(1, 0, 10) MK_PH(1, 1, 11) MK_PH(1, 2, 12) MK_PH(1, 3, 13) MK_PH(1, 4, 14) MK_PH(1, 5, 15) MK_PH(1, 6, 16) MK_PH(1, 7, 17)
    run_phase<1>(wv, 8, lds);
}
#endif

extern "C" void kernel_launch(void* const* d_in, const int* in_sizes, int n_in, void* d_out, int out_size, void* d_ws, size_t ws_size, hipStream_t stream) {
    (void)in_sizes; (void)n_in; (void)out_size;
    Params p{};
    const float* const* in = (const float* const*)d_in;
    p.x = in[0]; p.p = in[1]; p.mix_norm_g = in[2]; p.w_in = in[3]; p.w_out = in[4]; p.rel_bias = in[5]; p.a_qnorm = in[6]; p.a_knorm = in[7]; p.a_lambda = in[8]; p.a_subln = in[9];
    p.h_lb = in[10]; p.h_onorm = in[11]; p.c_w = in[12]; p.c_b = in[13]; p.c_scale = in[14]; p.r_mu = in[15]; p.r_w0 = in[16]; p.r_w2 = in[17]; p.r_a0 = in[18]; p.r_a2 = in[19];
    p.r_g2 = in[20]; p.r_kk = in[21]; p.r_ka = in[22]; p.r_rk = in[23]; p.r_gn_g = in[24]; p.r_gn_b = in[25]; p.mlp_norm_g = in[26]; p.w_up = in[27]; p.w_down = in[28];
    p.ple_norm_g = in[29]; p.w_ple = in[30]; p.w_gate = in[31];
    p.out = (float*)d_out;
    unsigned char* w = (unsigned char*)d_ws; size_t off = 0;
    auto take = [&](size_t bytes) { unsigned char* r = w + off; off += (bytes + 255) & ~(size_t)255; return r; };
    p.R0 = (u16*)take((size_t)T_TOK * DFF * 2);
    const size_t zbytes = (size_t)T_TOK * NIN * 2;
    p.ob = (u16*)((unsigned char*)p.R0 + zbytes);
    p.yb = p.ob + (size_t)T_TOK * 512;
    p.qmb = p.yb + (size_t)T_TOK * 512;
    p.mix = (u16*)take((size_t)T_TOK * DM * 2);
    p.hb0 = (u16*)take((size_t)T_TOK * DM * 2);
    p.Wt_in = (u16*)take((size_t)NINP * DM * 2);
    p.Wt_out = (u16*)take((size_t)DM * DM * 2);
    p.Wt_up = (u16*)take((size_t)DFF * DM * 2);
    p.Wt_down = (u16*)take((size_t)DM * DFF * 2);
    p.Wt_gate = (u16*)take((size_t)DM * DM * 2);
    p.Wt_ple = (u16*)take((size_t)DM * 256 * 2);
    p.pb = (u16*)take((size_t)T_TOK * 256 * 2);
    { unsigned char* r4 = (unsigned char*)p.Wt_up; for (int i = 0; i < 4; ++i) p.ra[i] = (_Float16*)(r4 + (size_t)i * T_TOK * 512 * 2);
      for (int i = 0; i < 4; ++i) p.ra[4 + i] = (_Float16*)((unsigned char*)p.hb0 + (size_t)i * T_TOK * 512 * 2);
      p.ra[8] = (_Float16*)take((size_t)T_TOK * 512 * 2); }
    p.hv = (float*)take((size_t)2 * 2 * 128 * 4 * 256 * 4);
    p.ss0 = (float*)take((size_t)T_TOK * 32 * 4);
    p.ss1 = (float*)take((size_t)T_TOK * 32 * 4);
    p.ctr = (unsigned*)take(256);
    if (off > ws_size) fprintf(stderr, "workspace too small: need %zu have %zu\n", off, ws_size);
    constexpr size_t kLds = 131072;
    hipMemsetAsync(p.ctr, 0, 256, stream);
#if FUSED_LAUNCH
    static int grid_blocks = 0;
    if (!grid_blocks) {
        hipFuncSetAttribute((const void*)mk_forward, hipFuncAttributeMaxDynamicSharedMemorySize, (int)kLds);
        int dev = 0, cus = 0, per_cu = 0;
        hipGetDevice(&dev);
        hipDeviceGetAttribute(&cus, hipDeviceAttributeMultiprocessorCount, dev);
        hipOccupancyMaxActiveBlocksPerMultiprocessor(&per_cu, mk_forward, 512, kLds);
        if (per_cu < 1) per_cu = 1;
        grid_blocks = cus;
    }
    void* args[] = {&p};
    hipError_t e = hipLaunchCooperativeKernel((const void*)mk_forward, dim3(grid_blocks), dim3(512), args, kLds, stream);
    if (e != hipSuccess) fprintf(stderr, "cooperative launch failed: %s (grid %d)\n", hipGetErrorString(e), grid_blocks);
#else
    static int inited = 0;
    if (!inited) { hipFuncSetAttribute((const void*)mk_phase, hipFuncAttributeMaxDynamicSharedMemorySize, (int)kLds); inited = 1; }
    for (int ph = 0; ph < NPH; ++ph) mk_phase<<<256, 512, kLds, stream>>>(p, ph);
#endif
}
```
